# Optimizing an MI355X kernel written in HIP

```python
import jax, jax.numpy as jnp
from jax import lax
import numpy as np

D_MODEL = 1024
BATCH = 8
SEQ = 2048
DEPTH = 2
DEC_BATCH = 2
DEC_SEQ = 8192
PAST_LEN = 128

MLA_HEADS = 16
QK_NOPE = 64
QK_ROPE = 32
V_HEAD = 64
Q_LORA = 768
KV_LORA = 256
ROPE_THETA = 10000.0
Q_BLOCK = 128
RWKV_HEAD = 64
RWKV_HEADS = D_MODEL // RWKV_HEAD
DECAY_LORA = 64
ICLR_LORA = 64
GATE_LORA = 160
GN_EPS = 64e-5
D_FF = 4 * D_MODEL
LN_EPS = 1e-5
RMS_EPS = 1e-6
ALPHA = (2 * DEPTH) ** 0.25
BETA = (8 * DEPTH) ** -0.25
N_MLA = (DEPTH + 1) // 2
N_RWKV = DEPTH // 2

kernel_name = "hybrid_mla_rwkv7_deepnorm_encoder"


def _layernorm(x, g, b):
    xf = x.astype(jnp.float32)
    mu = xf.mean(-1, keepdims=True)
    var = jnp.square(xf - mu).mean(-1, keepdims=True)
    return ((xf - mu) * lax.rsqrt(var + LN_EPS)).astype(x.dtype) * g + b


def _rmsnorm(x, g):
    xf = x.astype(jnp.float32)
    return (xf * lax.rsqrt(jnp.mean(xf * xf, -1, keepdims=True) + RMS_EPS)).astype(x.dtype) * g


def _rope_tables(seq, dtype):
    inv = 1.0 / (ROPE_THETA ** (jnp.arange(0, QK_ROPE, 2, dtype=jnp.float32) / QK_ROPE))
    ang = jnp.arange(seq, dtype=jnp.float32)[:, None] * inv[None, :]
    return jnp.cos(ang).astype(dtype), jnp.sin(ang).astype(dtype)


def _rope(x, cos, sin):
    half = QK_ROPE // 2
    x1, x2 = x[..., :half], x[..., half:]
    return jnp.concatenate([x1 * cos - x2 * sin, x2 * cos + x1 * sin], axis=-1)


def _mla(x, w_in, q_norm, kv_norm, w_qb, w_kvb, w_o):
    B, S, _ = x.shape
    H = MLA_HEADS
    h = x @ w_in
    c_q, c_kv, k_rope = jnp.split(h, [Q_LORA, Q_LORA + KV_LORA], axis=-1)
    c_q = _rmsnorm(c_q, q_norm)
    c_kv = _rmsnorm(c_kv, kv_norm)
    q = (c_q @ w_qb).reshape(B, S, H, QK_NOPE + QK_ROPE)
    q_nope, q_rope = q[..., :QK_NOPE], q[..., QK_NOPE:]
    kv = (c_kv @ w_kvb).reshape(B, S, H, QK_NOPE + V_HEAD)
    k_nope, v = kv[..., :QK_NOPE], kv[..., QK_NOPE:]
    cos, sin = _rope_tables(S, x.dtype)
    q_rope = _rope(q_rope, cos[:, None, :], sin[:, None, :])
    k_rope = _rope(k_rope, cos, sin)
    scale = (QK_NOPE + QK_ROPE) ** -0.5
    nb = S // Q_BLOCK
    qn = jnp.moveaxis((q_nope * scale).reshape(B, nb, Q_BLOCK, H, QK_NOPE), 1, 0)
    qr = jnp.moveaxis((q_rope * scale).reshape(B, nb, Q_BLOCK, H, QK_ROPE), 1, 0)

    def block(args):
        qn_b, qr_b = args
        s = (jnp.einsum('bqhd,bkhd->bhqk', qn_b, k_nope)
             + jnp.einsum('bqhr,bkr->bhqk', qr_b, k_rope))
        p = jax.nn.softmax(s.astype(jnp.float32), axis=-1).astype(v.dtype)
        return jnp.einsum('bhqk,bkhd->bqhd', p, v)

    o = lax.map(block, (qn, qr))
    o = jnp.moveaxis(o, 0, 1).reshape(B, S, H * V_HEAD)
    return o @ w_o


def _centred_shift(x):
    prev = jnp.pad(x[:, :-1], ((0, 0), (1, 0), (0, 0)))
    nxt = jnp.pad(x[:, 1:], ((0, 0), (0, 1), (0, 0)))
    return 0.5 * (prev + nxt) - x


def _heads(t):
    return t.reshape(t.shape[:-1] + (RWKV_HEADS, RWKV_HEAD))


def _wkv7_step(state, inp):
    r_t, w_t, k_t, v_t, a_t, b_t = inp
    sa = jnp.einsum('dbhij,dbhj->dbhi', state, a_t)
    state = (state * w_t[..., None, :] + sa[..., :, None] * b_t[..., None, :]
             + v_t[..., :, None] * k_t[..., None, :])
    return state, jnp.einsum('dbhij,dbhj->dbhi', state, r_t)


def _rwkv7(x, mix, w_r, w_k, w_v, w_o, w0, w1, w2, a0, a1, a2, g1, g2, k_k, k_a, r_k, lnx_g, lnx_b):
    B, S, D = x.shape
    f32 = jnp.float32
    xx = _centred_shift(x)
    xs = x[None] + xx[None] * mix[:, None, None, :]
    xr, xw, xk, xv, xa, xg = xs[0], xs[1], xs[2], xs[3], xs[4], xs[5]
    r = xr @ w_r
    k = xk @ w_k
    v = xv @ w_v
    dec = w0[:, None, None, :] + jnp.einsum('ebsl,eld->ebsd', jnp.tanh(jnp.einsum('bsd,edl->ebsl', xw, w1)), w2)
    logw = -jax.nn.softplus(-dec.astype(f32)) - 0.5
    decay = jnp.exp(-jnp.exp(logw))
    a = jax.nn.sigmoid(a0[:, None, None, :] + jnp.einsum('ebsl,eld->ebsd', jnp.einsum('bsd,edl->ebsl', xa, a1), a2))
    g = jax.nn.sigmoid(xg @ g1) @ g2
    kk = _heads((k * k_k).astype(f32))
    kk = kk / jnp.maximum(jnp.linalg.norm(kk, axis=-1, keepdims=True), 1e-12)
    a_h = _heads(a.astype(f32))
    k_dir = _heads(k.astype(f32))[None] * (1.0 + (a_h - 1.0) * _heads(k_a.astype(f32)))
    r_h = _heads(r.astype(f32))
    v_h = _heads(v.astype(f32))

    def seq_first(t2):
        t2 = jnp.stack([t2[0], jnp.flip(t2[1], axis=1)])
        return jnp.moveaxis(t2, 2, 0)

    def both(t):
        return seq_first(jnp.broadcast_to(t[None], (2,) + t.shape))

    inputs = (both(r_h), seq_first(_heads(decay)), seq_first(k_dir), both(v_h),
              both(-kk), seq_first(kk[None] * a_h))
    state0 = jnp.zeros((2, B, RWKV_HEADS, RWKV_HEAD, RWKV_HEAD), f32)
    _, ys = lax.scan(_wkv7_step, state0, inputs)
    y = jnp.moveaxis(ys[:, 0] + jnp.flip(ys[:, 1], axis=0), 0, 1)
    mu = y.mean(-1, keepdims=True)
    var = jnp.square(y - mu).mean(-1, keepdims=True)
    y_n = ((y - mu) * lax.rsqrt(var + GN_EPS)).reshape(B, S, D) * lnx_g + lnx_b
    bonus = jnp.sum(jnp.sum(r_h[None] * k_dir * r_k, axis=-1, keepdims=True), axis=0) * v_h
    out = (y_n + bonus.reshape(B, S, D)).astype(x.dtype) * g
    return out @ w_o


def _sqrelu_mlp(x, w1, w2):
    return jnp.square(jax.nn.relu(x @ w1)) @ w2


def setup_inputs(seed: int = 0) -> dict:
    key = jax.random.key(seed)
    ks = jax.random.split(key, 40)
    counter = iter(range(40))
    D = D_MODEL

    def nrm(shape, scale):
        return jax.random.normal(ks[next(counter)], shape, jnp.float32) * scale

    def gain(shape):
        return 1.0 + nrm(shape, 0.02)

    inp = {}
    inp["x_prompt"] = nrm((BATCH, SEQ, D), 1.0)
    inp["x_sample"] = nrm((DEC_BATCH, DEC_SEQ, D), 1.0)
    inp["mla_w_in"] = nrm((N_MLA, D, Q_LORA + KV_LORA + QK_ROPE), D ** -0.5)
    inp["mla_q_norm"] = gain((N_MLA, Q_LORA))
    inp["mla_kv_norm"] = gain((N_MLA, KV_LORA))
    inp["mla_w_qb"] = nrm((N_MLA, Q_LORA, MLA_HEADS * (QK_NOPE + QK_ROPE)), Q_LORA ** -0.5)
    inp["mla_w_kvb"] = nrm((N_MLA, KV_LORA, MLA_HEADS * (QK_NOPE + V_HEAD)), KV_LORA ** -0.5)
    inp["mla_w_o"] = nrm((N_MLA, MLA_HEADS * V_HEAD, D), BETA * (MLA_HEADS * V_HEAD) ** -0.5)
    inp["rwkv_mix"] = jax.random.uniform(ks[next(counter)], (N_RWKV, 6, D), jnp.float32, 0.05, 0.95)
    inp["rwkv_w_r"] = nrm((N_RWKV, D, D), D ** -0.5)
    inp["rwkv_w_k"] = nrm((N_RWKV, D, D), D ** -0.5)
    inp["rwkv_w_v"] = nrm((N_RWKV, D, D), D ** -0.5)
    inp["rwkv_w_o"] = nrm((N_RWKV, D, D), BETA * D ** -0.5)
    inp["rwkv_w0"] = jnp.linspace(-6.5, -1.5, D, dtype=jnp.float32) + nrm((N_RWKV, 2, D), 0.1)
    inp["rwkv_w1"] = nrm((N_RWKV, 2, D, DECAY_LORA), D ** -0.5)
    inp["rwkv_w2"] = nrm((N_RWKV, 2, DECAY_LORA, D), 0.1 * DECAY_LORA ** -0.5)
    inp["rwkv_a0"] = nrm((N_RWKV, 2, D), 0.1)
    inp["rwkv_a1"] = nrm((N_RWKV, 2, D, ICLR_LORA), D ** -0.5)
    inp["rwkv_a2"] = nrm((N_RWKV, 2, ICLR_LORA, D), 0.1 * ICLR_LORA ** -0.5)
    inp["rwkv_g1"] = nrm((N_RWKV, D, GATE_LORA), D ** -0.5)
    inp["rwkv_g2"] = nrm((N_RWKV, GATE_LORA, D), GATE_LORA ** -0.5)
    inp["rwkv_k_k"] = 0.85 + nrm((N_RWKV, D), 0.02)
    inp["rwkv_k_a"] = gain((N_RWKV, D))
    inp["rwkv_r_k"] = nrm((N_RWKV, RWKV_HEADS, RWKV_HEAD), 0.1)
    inp["rwkv_lnx_g"] = gain((N_RWKV, D))
    inp["rwkv_lnx_b"] = nrm((N_RWKV, D), 0.02)
    inp["mlp_w1"] = nrm((DEPTH, D, D_FF), D ** -0.5)
    inp["mlp_w2"] = nrm((DEPTH, D_FF, D), BETA * D_FF ** -0.5)
    inp["ln1_g"] = gain((DEPTH, D))
    inp["ln1_b"] = nrm((DEPTH, D), 0.02)
    inp["ln2_g"] = gain((DEPTH, D))
    inp["ln2_b"] = nrm((DEPTH, D), 0.02)
    return inp


def reference(x_prompt, x_sample, mla_w_in, mla_q_norm, mla_kv_norm, mla_w_qb, mla_w_kvb, mla_w_o,
              rwkv_mix, rwkv_w_r, rwkv_w_k, rwkv_w_v, rwkv_w_o, rwkv_w0, rwkv_w1, rwkv_w2,
              rwkv_a0, rwkv_a1, rwkv_a2, rwkv_g1, rwkv_g2, rwkv_k_k, rwkv_k_a, rwkv_r_k,
              rwkv_lnx_g, rwkv_lnx_b, mlp_w1, mlp_w2, ln1_g, ln1_b, ln2_g, ln2_b):
    mla = (mla_w_in, mla_q_norm, mla_kv_norm, mla_w_qb, mla_w_kvb, mla_w_o)
    rwkv = (rwkv_mix, rwkv_w_r, rwkv_w_k, rwkv_w_v, rwkv_w_o, rwkv_w0, rwkv_w1, rwkv_w2,
            rwkv_a0, rwkv_a1, rwkv_a2, rwkv_g1, rwkv_g2, rwkv_k_k, rwkv_k_a, rwkv_r_k,
            rwkv_lnx_g, rwkv_lnx_b)

    def trunk(x):
        for i in range(DEPTH):
            j = i // 2
            if i % 2 == 0:
                h = _mla(x, *[t[j] for t in mla])
            else:
                h = _rwkv7(x, *[t[j] for t in rwkv])
            x = _layernorm(ALPHA * x + h, ln1_g[i], ln1_b[i])
            x = _layernorm(ALPHA * x + _sqrelu_mlp(x, mlp_w1[i], mlp_w2[i]), ln2_g[i], ln2_b[i])
        return x

    y_prompt = trunk(x_prompt)
    y_sample = trunk(x_sample)
    return (y_prompt, y_sample)
```

```cpp
#include <hip/hip_runtime.h>
#include <hip/hip_cooperative_groups.h>
#include <cstdio>
#include <cstdint>
namespace cg = cooperative_groups;

#ifndef ONLY
#define ONLY -1
#endif
#ifndef ONLY_MASK
#define ONLY_MASK 0xFFFFFFFFu
#endif
#define CASE_ON(k) (((ONLY_MASK) >> (k)) & 1u)
#ifndef ONE_LAUNCH
#define ONE_LAUNCH 1
#endif

#define LAS __attribute__((address_space(3)))
typedef unsigned short bf16;
typedef short bf16x8 __attribute__((ext_vector_type(8)));
typedef short s16x4 __attribute__((ext_vector_type(4)));
typedef float f32x4 __attribute__((ext_vector_type(4)));
typedef float f32x2 __attribute__((ext_vector_type(2)));
typedef float f32x16 __attribute__((ext_vector_type(16)));
typedef unsigned u32x4 __attribute__((ext_vector_type(4)));
typedef unsigned u32x2 __attribute__((ext_vector_type(2)));
typedef __bf16 bf16x2_t __attribute__((ext_vector_type(2)));

constexpr int DM = 1024, MH = 16384, DFF = 4096, NH = 16;
constexpr float ALPHA = 1.41421356237309515f;
constexpr float LN_EPS = 1e-5f, RMS_EPS = 1e-6f, GN_EPS = 64e-5f;
constexpr float QSCALE = 0.10206207261596575f * 1.4426950408889634f;
constexpr int NPH = 19;

constexpr size_t MiB = 1u << 20;
constexpr size_t OFF_WIN = 1 * MiB;
constexpr size_t OFF_WQB = OFF_WIN + 1280 * 1024 * 2;
constexpr size_t OFF_WK = OFF_WQB + 1536 * 768 * 2;
constexpr size_t OFF_WV = OFF_WK + 1024 * 256 * 2;
constexpr size_t OFF_WO0 = OFF_WV + 1024 * 256 * 2;
constexpr size_t OFF_W1 = 9 * MiB;
constexpr size_t OFF_W2 = 25 * MiB;
constexpr size_t OFF_WBIG = 41 * MiB;
constexpr size_t OFF_BG = 55 * MiB;
constexpr size_t OFF_WO1 = OFF_BG + 1024 * 256 * 2;
constexpr size_t OFF_W2T = OFF_WO1 + 1024 * 1024 * 2;
constexpr size_t OFF_A2T = OFF_W2T + 2 * 1024 * 64 * 2;
constexpr size_t OFF_ROPE = 58 * MiB;
constexpr size_t ACT0 = 60 * MiB;
constexpr size_t A_XB = ACT0 + 0 * MiB, A_CQ = ACT0 + 32 * MiB, A_CKV = ACT0 + 56 * MiB, A_KROPE = ACT0 + 64 * MiB, A_SSQ = ACT0 + 65 * MiB;
constexpr size_t A_Q = ACT0 + 66 * MiB, A_KN = ACT0 + 114 * MiB, A_VT = ACT0 + 146 * MiB, A_O = ACT0 + 0 * MiB;
constexpr size_t A_XNB = ACT0 + 160 * MiB, A_HID = ACT0 + 0 * MiB;
constexpr size_t A_X2 = ACT0 + 0 * MiB, A_A2 = ACT0 + 64 * MiB, A_V = ACT0 + 128 * MiB, A_L = ACT0 + 160 * MiB, A_Y = ACT0 + 64 * MiB, A_COEF = ACT0 + 192 * MiB, A_OPOST = ACT0 + 160 * MiB;
constexpr size_t WS_NEED = 256 * MiB;
static_assert(OFF_WO0 + 1024 * 1024 * 2 <= OFF_W1 && OFF_A2T + 2 * 1024 * 64 * 2 <= OFF_ROPE, "ws map");

constexpr int LDS_BYTES = 147456;

__device__ __forceinline__ unsigned cvtpk(float lo, float hi) { f32x2 v = {lo, hi}; bf16x2_t b = __builtin_convertvector(v, bf16x2_t); return __builtin_bit_cast(unsigned, b); }
__device__ __forceinline__ bf16 f2bf(float f) { return (bf16)(cvtpk(f, 0.f) & 0xffffu); }
__device__ __forceinline__ float bf2f(bf16 b) { return __builtin_bit_cast(float, (unsigned)b << 16); }
__device__ __forceinline__ float sigmoidf_(float x) { return __builtin_amdgcn_rcpf(1.0f + __builtin_amdgcn_exp2f(-1.4426950408889634f * x)); }
__device__ __forceinline__ float wave_sum(float v) {
#pragma unroll
    for (int o = 1; o < 64; o <<= 1) v += __shfl_xor(v, o);
    return v;
}
template <int CTRL> __device__ __forceinline__ float dppf(float v) { return __builtin_bit_cast(float, __builtin_amdgcn_update_dpp(0, __builtin_bit_cast(int, v), CTRL, 0xf, 0xf, false)); }
__device__ __forceinline__ float allred4(float v) { v += dppf<0xB1>(v); v += dppf<0x4E>(v); return v; }
__device__ __forceinline__ float allred8(float v) { v += dppf<0xB1>(v); v += dppf<0x4E>(v); v += dppf<0x141>(v); return v; }
__device__ __forceinline__ float allred16(float v) { v = allred8(v); v += dppf<0x140>(v); return v; }

struct Job { const float* src; const float* ksc; bf16* dst; int ld_src, Ksrc, col0, cpb, cstride, ld_dst, row0, kcol0, nkt, nnb, item0, pad0, pad1, pad2; };
constexpr int NJOBS = 31;
struct Args {
    const float* in[32];
    float* out; unsigned char* ws;
    int ph_lo, ph_hi, coop, njobs_items;
    Job jobs[NJOBS];
};

namespace pg8 {
constexpr int BM = 256, BK = 64, HALF = 128, HTB = HALF * BK * 2, STAGE_BYTES = 8 * HTB, NXCD = 8, WGM = 8;
__device__ __forceinline__ int lds_byte(int r, int c) { const int st = (r >> 4) * 2 + (c >> 5), rr = r & 15, cc = c & 31, ob = rr * 64 + cc * 2; return st * 1024 + (ob ^ (((ob >> 9) & 1) << 5)); }
__device__ __forceinline__ void stage_rc(int b, int& R, int& C) { const int st = b / 1024, sb = b % 1024, swz = sb ^ (((sb >> 9) & 1) << 5); R = (st >> 1) * 16 + swz / 64; C = (st & 1) * 32 + (swz % 64) / 2; }
__device__ __forceinline__ int perm32(int rho) { const int n = rho >> 4, i = rho & 15; return 8 * (i >> 2) + 4 * n + (i & 3); }
struct Unit { int pm, pn; };
struct Gemm { const bf16* A; const bf16* Bt; int M, N, K, lda, ldb; };
struct StaticOrder {
    int nM, nN, nwg, G, c;
    __device__ void init(int M, int N, int G_, int c_) { nM = M / BM; nN = N / BM; nwg = nM * nN; G = G_; c = c_; }
    __device__ bool next(int i, Unit& u) const {
        const long L = (long)i * G + c; if (L >= nwg) return false;
        int wgid = (int)L; { const int q = nwg / NXCD, r = nwg % NXCD, xcd = wgid % NXCD, off = wgid / NXCD; wgid = (xcd < r ? xcd * (q + 1) : r * (q + 1) + (xcd - r) * q) + off; }
        const int nig = WGM * nN, gid = wgid / nig, fm = gid * WGM, gsz = (nM - fm) < WGM ? (nM - fm) : WGM;
        u.pm = fm + ((wgid % nig) % gsz); u.pn = (wgid % nig) / gsz; return true;
    }
};
struct GemmDesc { const bf16* A; const bf16* Bt; int M, N, K, lda, ldb, mode, perm, i0; void* p0; void* p1; void* p2; void* p3; void* p4; };
typedef const f32x4 (&AccRef)[2][2][4][2];
typedef const __attribute__((address_space(4))) Args* ArgP;
__device__ __forceinline__ void fill_desc(GemmDesc& d, int ph, int sub, ArgP ap) {
    unsigned char* ws = ap->ws;
    const int half = ph / NPH, k = ph % NPH;
    float* DH = ap->out + (size_t)half * MH * DM;
    const int smask = half ? 8191 : 2047;
    float* rope = (float*)(ws + OFF_ROPE);
    d.M = MH; d.N = DM; d.K = DM; d.lda = DM; d.ldb = DM; d.mode = 7; d.perm = 1; d.i0 = 0;
    d.A = nullptr; d.Bt = nullptr; d.p0 = nullptr; d.p1 = nullptr; d.p2 = nullptr; d.p3 = nullptr; d.p4 = nullptr;
    if (k == 1) { d.A = (const bf16*)(ws + A_XB); d.Bt = (const bf16*)(ws + OFF_WIN); d.N = 1280; d.mode = 0; d.perm = 0; d.i0 = smask;
        d.p0 = ws + A_CQ; d.p1 = ws + A_CKV; d.p2 = ws + A_KROPE; d.p3 = ws + A_SSQ; d.p4 = rope; }
    else if (k == 2 && sub == 0) { d.A = (const bf16*)(ws + A_CQ); d.Bt = (const bf16*)(ws + OFF_WQB); d.N = 1536; d.K = 768; d.lda = 768; d.ldb = 768; d.mode = 1; d.perm = 0; d.i0 = smask;
        d.p0 = ws + A_Q; d.p3 = ws + A_SSQ; d.p4 = rope; }
    else if (k == 2 && sub == 1) { d.A = (const bf16*)(ws + A_CKV); d.Bt = (const bf16*)(ws + OFF_WK); d.K = 256; d.lda = 256; d.ldb = 256; d.mode = 2; d.p0 = ws + A_KN; d.p3 = ws + A_SSQ; }
    else if (k == 2) { d.A = (const bf16*)(ws + OFF_WV); d.Bt = (const bf16*)(ws + A_CKV); d.M = 1024; d.N = MH; d.K = 256; d.lda = 256; d.ldb = 256; d.mode = 3; d.p0 = ws + A_VT; d.p3 = ws + A_SSQ; }
    else if (k == 4) { d.A = (const bf16*)(ws + A_O); d.Bt = (const bf16*)(ws + OFF_WO0); d.mode = 8; d.perm = 0; d.p0 = DH; d.p1 = (void*)ap->in[half];
        d.p2 = (void*)ap->in[28]; d.p3 = (void*)ap->in[29]; d.p4 = ws + A_XNB; d.i0 = half * 3; }
    else if (k == 6 || k == 16) { d.A = (const bf16*)(ws + (k == 16 ? A_V : A_XNB)); d.Bt = (const bf16*)(ws + OFF_W1) + (size_t)(k == 16) * DFF * DM; d.N = DFF; d.mode = 5; d.p0 = ws + A_HID; }
    else if (k == 7 || k == 17) { d.A = (const bf16*)(ws + A_HID); d.Bt = (const bf16*)(ws + OFF_W2) + (size_t)(k == 17) * DFF * DM; d.K = DFF; d.lda = DFF; d.ldb = DFF; d.mode = 4; d.perm = 0; d.p0 = DH; d.p1 = DH;
        if (k == 17) { d.mode = 8; d.p2 = (void*)(ap->in[30] + DM); d.p3 = (void*)(ap->in[31] + DM); d.p4 = nullptr; d.i0 = half * 3 + 1; } }
    else if (k == 9) { d.A = (const bf16*)(ws + A_A2); d.Bt = (const bf16*)(ws + OFF_WBIG); d.N = 3584; d.K = 2048; d.lda = 2048; d.ldb = 2048; d.mode = 6;
        d.p0 = DH; d.p1 = (bf16*)DH + (size_t)MH * DM; d.p2 = ws + A_V; d.p3 = ws + A_L; }
    else if (k == 12) { d.A = (const bf16*)(ws + A_L) + 256; d.Bt = (const bf16*)(ws + OFF_BG); d.K = 256; d.lda = 512; d.ldb = 256; d.mode = 7; d.i0 = DM; d.p0 = DH; }
    else { d.A = (const bf16*)(ws + A_OPOST); d.Bt = (const bf16*)(ws + OFF_WO1); d.mode = 8; d.perm = 0; d.p0 = DH; d.p1 = ws + A_X2;
        d.p2 = (void*)(ap->in[28] + DM); d.p3 = (void*)(ap->in[29] + DM); d.p4 = ws + A_V; d.i0 = half * 3 + 2; }
}
__device__ __forceinline__ void epi_dispatch(const GemmDesc& d, AccRef acc, const Unit& u, int wr, int wc, int fr, int fq);
__device__ __forceinline__ void fused_ln(const GemmDesc& d, f32x4 (&acc)[2][2][4][2], const Unit& u, int wr, int wc, int fr, int fq, LAS unsigned char* lds, int wid, int lane, unsigned char* ws);
__device__ __forceinline__ void gemm_phase(LAS unsigned char* lds, int ph, int sub, ArgP ap0, int G_, int c_, const int tid_in) {
    int tid = tid_in; asm volatile("" : "+v"(tid));
    GemmDesc d0; fill_desc(d0, ph, sub, ap0);
    const Gemm g{d0.A, d0.Bt, d0.M, d0.N, d0.K, d0.lda, d0.ldb};
    StaticOrder S; S.init(d0.M, d0.N, G_, c_);
    const bool perm = d0.perm != 0;
    const int wid = __builtin_amdgcn_readfirstlane(tid >> 6), lane = tid & 63, wr = wid >> 2, wc = wid & 3, fr = lane & 15, fq = lane >> 4;
    const int K = g.K, nt = K / BK;
    unsigned voffA[2], voffB[2];
#pragma unroll
    for (int i = 0; i < 2; ++i) { int R, C; stage_rc(tid * 16 + i * 8192, R, C); const int Rb = perm ? ((R & ~31) + perm32(R & 31)) : R;
        voffA[i] = (unsigned)(R * g.lda + C) * 2u; voffB[i] = (unsigned)(Rb * g.ldb + C) * 2u; }
    const size_t kstep = (size_t)(BK * 2);
    const unsigned hstepA = (unsigned)HALF * g.lda * 2u, hstepB = (unsigned)HALF * g.ldb * 2u;
    const unsigned tstepA = 2u * hstepA, tstepB = 2u * hstepB;
    const unsigned ldsw = (unsigned)wid * 1024u;
    const int aoff = lds_byte(wr * 64 + fr, fq * 8), boff = lds_byte(wc * 32 + fr, fq * 8);
#define PG8_SA(b, h) (((b) * 2 + (h)) * HTB)
#define PG8_SB(b, h) ((4 + (b) * 2 + (h)) * HTB)
#define PG8_STAGE(bufoff, gbase, voff) do { _Pragma("unroll") for (int _i = 0; _i < 2; ++_i) \
        __builtin_amdgcn_global_load_lds((const unsigned*)((const char*)(gbase) + (voff)[_i]), (LAS unsigned*)(lds + (bufoff) + ldsw + _i * 8192), 16, 0, 0); } while (0)
#define PG8_LDA(dst, b, h) do { _Pragma("unroll") for (int m = 0; m < 4; ++m) _Pragma("unroll") for (int k = 0; k < 2; ++k) dst[m][k] = *(const LAS bf16x8*)(lds + PG8_SA(b, h) + aoff + m * 2048 + k * 1024); } while (0)
#define PG8_LDB(dst, b, h) do { _Pragma("unroll") for (int n = 0; n < 2; ++n) _Pragma("unroll") for (int k = 0; k < 2; ++k) dst[n][k] = *(const LAS bf16x8*)(lds + PG8_SB(b, h) + boff + n * 2048 + k * 1024); } while (0)
#define PG8_MMA(ai, bj, At, Bt) do { __builtin_amdgcn_s_setprio(1); _Pragma("unroll") for (int m = 0; m < 4; ++m) _Pragma("unroll") for (int n = 0; n < 2; ++n) _Pragma("unroll") for (int k = 0; k < 2; ++k) \
        acc[ai][bj][m][n] = __builtin_amdgcn_mfma_f32_16x16x32_bf16(Bt[n][k], At[m][k], acc[ai][bj][m][n], 0, 0, 0); __builtin_amdgcn_s_setprio(0); } while (0)
#define PG8_WAIT_V(n) asm volatile("s_waitcnt vmcnt(" #n ")" ::: "memory")
#define PG8_WAIT_L(n) asm volatile("s_waitcnt lgkmcnt(" #n ")" ::: "memory")
#define PG8_BAR __builtin_amdgcn_s_barrier()
#define PG8_SCHED __builtin_amdgcn_sched_barrier(0)
    Unit cur, nxt; int ui = 0;
    if (!S.next(0, cur)) return;
    f32x4 acc[2][2][4][2];
#pragma unroll
    for (int a = 0; a < 2; ++a)
#pragma unroll
        for (int b = 0; b < 2; ++b)
#pragma unroll
            for (int m = 0; m < 4; ++m)
#pragma unroll
                for (int n = 0; n < 2; ++n) acc[a][b][m][n] = (f32x4){0.f, 0.f, 0.f, 0.f};
    bf16x8 At[4][2], B0[2][2], B1[2][2];
    const char* cA = (const char*)g.A + (size_t)cur.pm * tstepA; const char* cB = (const char*)g.Bt + (size_t)cur.pn * tstepB;
    PG8_STAGE(PG8_SB(0, 0), cB, voffB); PG8_STAGE(PG8_SB(0, 1), cB + hstepB, voffB); PG8_STAGE(PG8_SA(0, 0), cA, voffA); PG8_STAGE(PG8_SA(0, 1), cA + hstepA, voffA);
    if (wr == 1) PG8_BAR;
    PG8_WAIT_V(2); PG8_BAR;
    PG8_STAGE(PG8_SB(1, 0), cB + kstep, voffB); PG8_STAGE(PG8_SA(1, 0), cA + kstep, voffA); PG8_STAGE(PG8_SB(1, 1), cB + hstepB + kstep, voffB);
    PG8_WAIT_V(6); PG8_BAR;
    for (;;) {
        const bool has_next = S.next(ui + 1, nxt);
        const char* nA = has_next ? (const char*)g.A + (size_t)nxt.pm * tstepA : cA; const char* nB = has_next ? (const char*)g.Bt + (size_t)nxt.pn * tstepB : cB;
        for (int t = 0; t < nt; t += 2) {
            const bool last = (t == nt - 2);
            const char* a1 = cA + (size_t)(t + 1) * kstep;
            const char* a2 = last ? nA : cA + (size_t)(t + 2) * kstep; const char* b2 = last ? nB : cB + (size_t)(t + 2) * kstep;
            const char* a3 = a2 + kstep; const char* b3 = b2 + kstep;
            PG8_LDB(B0, 0, 0); PG8_LDB(B1, 0, 1); PG8_SCHED; PG8_LDA(At, 0, 0); PG8_STAGE(PG8_SA(1, 1), a1 + hstepA, voffA);
            PG8_WAIT_V(8); PG8_WAIT_L(0); PG8_BAR; PG8_MMA(0, 0, At, B0); PG8_MMA(0, 1, At, B1); PG8_BAR; PG8_SCHED;
            PG8_LDA(At, 0, 1); PG8_STAGE(PG8_SB(0, 0), b2, voffB); PG8_STAGE(PG8_SB(0, 1), b2 + hstepB, voffB); PG8_STAGE(PG8_SA(0, 0), a2, voffA);
            PG8_WAIT_V(8); PG8_WAIT_L(0); PG8_BAR; PG8_MMA(1, 0, At, B0); PG8_MMA(1, 1, At, B1); PG8_BAR; PG8_SCHED;
            PG8_LDB(B0, 1, 0); PG8_LDB(B1, 1, 1); PG8_SCHED; PG8_LDA(At, 1, 0); PG8_STAGE(PG8_SA(0, 1), a2 + hstepA, voffA);
            PG8_WAIT_V(8); PG8_WAIT_L(0); PG8_BAR; PG8_MMA(0, 0, At, B0); PG8_MMA(0, 1, At, B1); PG8_BAR; PG8_SCHED;
            PG8_LDA(At, 1, 1); PG8_STAGE(PG8_SB(1, 0), b3, voffB); PG8_STAGE(PG8_SB(1, 1), b3 + hstepB, voffB); PG8_STAGE(PG8_SA(1, 0), a3, voffA);
            PG8_WAIT_V(8); PG8_WAIT_L(0); PG8_BAR; PG8_MMA(1, 0, At, B0); PG8_MMA(1, 1, At, B1); PG8_BAR; PG8_SCHED;
        }
        if (wr == 0) PG8_BAR;
        { int ph2 = ph, sub2 = sub; ArgP ap2 = ap0; asm volatile("" : "+s"(ph2), "+s"(sub2), "+s"(ap2));
          int t3 = tid; asm volatile("" : "+v"(t3)); const int wid3 = __builtin_amdgcn_readfirstlane(t3 >> 6), lane3 = t3 & 63;
          GemmDesc d; fill_desc(d, ph2, sub2, ap2); epi_dispatch(d, acc, cur, wid3 >> 2, wid3 & 3, lane3 & 15, lane3 >> 4); }
        if (!has_next) break;
#pragma unroll
        for (int a = 0; a < 2; ++a)
#pragma unroll
            for (int b = 0; b < 2; ++b)
#pragma unroll
                for (int m = 0; m < 4; ++m)
#pragma unroll
                    for (int n = 0; n < 2; ++n) acc[a][b][m][n] = (f32x4){0.f, 0.f, 0.f, 0.f};
        cur = nxt; cA = nA; cB = nB; ++ui;
        if (wr == 1) PG8_BAR;
    }
    PG8_WAIT_V(0);
    PG8_BAR;
    { int ph2 = ph, sub2 = sub; ArgP ap2 = ap0; asm volatile("" : "+s"(ph2), "+s"(sub2), "+s"(ap2));
      GemmDesc d; fill_desc(d, ph2, sub2, ap2);
      if (d.mode == 8) { int t2 = tid; asm volatile("" : "+v"(t2));
          const int wid2 = __builtin_amdgcn_readfirstlane(t2 >> 6), lane2 = t2 & 63;
          fused_ln(d, acc, cur, wid2 >> 2, wid2 & 3, lane2 & 15, lane2 >> 4, lds, wid2, lane2, ap2->ws); } }
#undef PG8_SA
#undef PG8_SB
#undef PG8_STAGE
#undef PG8_LDA
#undef PG8_LDB
#undef PG8_MMA
#undef PG8_WAIT_V
#undef PG8_WAIT_L
#undef PG8_BAR
#undef PG8_SCHED
}

__device__ __forceinline__ void st_bf16x4(bf16* p, f32x4 v) { u32x2 w; w.x = cvtpk(v[0], v[1]); w.y = cvtpk(v[2], v[3]); *(u32x2*)p = w; }
__device__ __forceinline__ void st_bf16x8(bf16* p, f32x4 v0, f32x4 v1) { u32x4 w; w.x = cvtpk(v0[0], v0[1]); w.y = cvtpk(v0[2], v0[3]); w.z = cvtpk(v1[0], v1[1]); w.w = cvtpk(v1[2], v1[3]); *(u32x4*)p = w; }

struct EpiP1 {
    static constexpr bool PERM = false;
    bf16* cq; bf16* ckv; bf16* krope; float* ssq; const float* rope; int smask;
    __device__ __forceinline__ void operator()(AccRef acc, const Unit& u, int wr, int wc, int fr, int fq) const {
        const int pn = u.pn;
        bf16* cq_ = cq; bf16* ckv_ = ckv;
        asm volatile("" : "+s"(cq_), "+s"(ckv_));
#pragma unroll
        for (int ai = 0; ai < 2; ++ai)
#pragma unroll
            for (int m = 0; m < 4; ++m) {
                asm volatile("" ::: "memory");
                const int row = u.pm * BM + ai * HALF + wr * 64 + m * 16 + fr;
                if (pn < 4) {
                    float s = 0.f;
#pragma unroll
                    for (int bj = 0; bj < 2; ++bj)
#pragma unroll
                        for (int n = 0; n < 2; ++n) { const f32x4 v = acc[ai][bj][m][n]; s += (v[0] * v[0] + v[1] * v[1]) + (v[2] * v[2] + v[3] * v[3]);
                            const int col = pn * BM + bj * HALF + wc * 32 + n * 16 + 4 * fq;
                            bf16* p = (pn < 3) ? cq_ + (size_t)row * 768 + col : ckv_ + (size_t)row * 256 + (col - 768);
                            st_bf16x4(p, v); }
                    s += __shfl_xor(s, 16); s += __shfl_xor(s, 32);
                    if (fq == 0) ssq[(size_t)row * 16 + pn * 4 + wc] = s;
                } else if (wc == 0) {
                    const f32x4 x1 = acc[ai][0][m][0], x2 = acc[ai][0][m][1];
                    const int pos = row & smask;
                    const f32x4 t0 = *(const f32x4*)(rope + ((size_t)pos * 16 + 4 * fq) * 2), t1 = *(const f32x4*)(rope + ((size_t)pos * 16 + 4 * fq) * 2 + 4);
                    const f32x4 c = {t0[0], t0[2], t1[0], t1[2]}, sn = {t0[1], t0[3], t1[1], t1[3]};
                    st_bf16x4(krope + (size_t)row * 32 + 4 * fq, x1 * c - x2 * sn);
                    st_bf16x4(krope + (size_t)row * 32 + 16 + 4 * fq, x2 * c + x1 * sn);
                }
            }
    }
};
struct EpiQ {
    static constexpr bool PERM = false;
    bf16* Q; const float* ssq; const float* rope; int smask;
    __device__ __forceinline__ void operator()(AccRef acc, const Unit& u, int wr, int wc, int fr, int fq) const {
#pragma unroll
        for (int ai = 0; ai < 2; ++ai)
#pragma unroll
            for (int m = 0; m < 4; ++m) {
                if ((m & 1) == 0) asm volatile("" ::: "memory");
                const int row = u.pm * BM + ai * HALF + wr * 64 + m * 16 + fr;
                const f32x4 s0 = *(const f32x4*)(ssq + (size_t)row * 16), s1 = *(const f32x4*)(ssq + (size_t)row * 16 + 4), s2 = *(const f32x4*)(ssq + (size_t)row * 16 + 8);
                const float ss = ((s0[0] + s0[1]) + (s0[2] + s0[3])) + ((s1[0] + s1[1]) + (s1[2] + s1[3])) + ((s2[0] + s2[1]) + (s2[2] + s2[3]));
                const float rs = __builtin_amdgcn_rsqf(ss * (1.0f / 768.0f) + RMS_EPS) * QSCALE;
                const int pos = row & smask;
#pragma unroll
                for (int bj = 0; bj < 2; ++bj) {
                    const int g = u.pn * 8 + bj * 4 + wc;
                    const int col = u.pn * BM + bj * HALF + wc * 32 + 4 * fq;
                    bf16* p = Q + (size_t)row * 1536 + col;
                    const f32x4 x1 = acc[ai][bj][m][0] * rs, x2 = acc[ai][bj][m][1] * rs;
                    if ((g % 3) == 2) {
                        const f32x4 t0 = *(const f32x4*)(rope + ((size_t)pos * 16 + 4 * fq) * 2), t1 = *(const f32x4*)(rope + ((size_t)pos * 16 + 4 * fq) * 2 + 4);
                        const f32x4 c = {t0[0], t0[2], t1[0], t1[2]}, sn = {t0[1], t0[3], t1[1], t1[3]};
                        st_bf16x4(p, x1 * c - x2 * sn); st_bf16x4(p + 16, x2 * c + x1 * sn);
                    } else { st_bf16x4(p, x1); st_bf16x4(p + 16, x2); }
                }
            }
    }
};
struct EpiKn {
    static constexpr bool PERM = true;
    bf16* Kn; const float* ssq;
    __device__ __forceinline__ void operator()(AccRef acc, const Unit& u, int wr, int wc, int fr, int fq) const {
        f32x4 s0[2][4];
#pragma unroll
        for (int ai = 0; ai < 2; ++ai)
#pragma unroll
            for (int m = 0; m < 4; ++m) s0[ai][m] = *(const f32x4*)(ssq + (size_t)(u.pm * BM + ai * HALF + wr * 64 + m * 16 + fr) * 16 + 12);
#pragma unroll
        for (int ai = 0; ai < 2; ++ai)
#pragma unroll
            for (int m = 0; m < 4; ++m) {
                const int row = u.pm * BM + ai * HALF + wr * 64 + m * 16 + fr;
                const float rs = __builtin_amdgcn_rsqf(((s0[ai][m][0] + s0[ai][m][1]) + (s0[ai][m][2] + s0[ai][m][3])) * (1.0f / 256.0f) + RMS_EPS);
#pragma unroll
                for (int bj = 0; bj < 2; ++bj) { const int col = u.pn * BM + bj * HALF + wc * 32 + 8 * fq;
                    st_bf16x8(Kn + (size_t)row * 1024 + col, acc[ai][bj][m][0] * rs, acc[ai][bj][m][1] * rs); }
            }
    }
};
struct EpiVt {
    static constexpr bool PERM = true;
    bf16* Vt; const float* ssq;
    __device__ __forceinline__ void operator()(AccRef acc, const Unit& u, int wr, int wc, int fr, int fq) const {
#pragma unroll
        for (int bj = 0; bj < 2; ++bj) {
            const int col = u.pn * BM + bj * HALF + wc * 32 + 8 * fq;
            float cs[8];
#pragma unroll
            for (int e = 0; e < 8; ++e) { const f32x4 s0 = *(const f32x4*)(ssq + (size_t)(col + e) * 16 + 12);
                cs[e] = __builtin_amdgcn_rsqf(((s0[0] + s0[1]) + (s0[2] + s0[3])) * (1.0f / 256.0f) + RMS_EPS); }
            asm volatile("" ::: "memory");
#pragma unroll
            for (int ai = 0; ai < 2; ++ai)
#pragma unroll
                for (int m = 0; m < 4; ++m) {
                    const int row = u.pm * BM + ai * HALF + wr * 64 + m * 16 + fr;
                    f32x4 v0 = acc[ai][bj][m][0], v1 = acc[ai][bj][m][1];
#pragma unroll
                    for (int e = 0; e < 4; ++e) { v0[e] *= cs[e]; v1[e] *= cs[4 + e]; }
                    st_bf16x8(Vt + (size_t)row * MH + col, v0, v1);
                }
            asm volatile("" ::: "memory");
        }
    }
};
struct EpiRes {
    static constexpr bool PERM = false;
    const float* res; float* out;
    __device__ __forceinline__ void operator()(AccRef acc, const Unit& u, int wr, int wc, int fr, int fq) const {
#pragma unroll
        for (int ai = 0; ai < 2; ++ai) {
            asm volatile("" ::: "memory");
            f32x4 rr[4][2][2];
#pragma unroll
            for (int m = 0; m < 4; ++m) {
                const size_t off = (size_t)(u.pm * BM + ai * HALF + wr * 64 + m * 16 + fr) * DM + u.pn * BM + wc * 32 + 4 * fq;
#pragma unroll
                for (int bj = 0; bj < 2; ++bj)
#pragma unroll
                    for (int n = 0; n < 2; ++n) rr[m][bj][n] = *(const f32x4*)(res + off + bj * HALF + n * 16);
            }
#pragma unroll
            for (int m = 0; m < 4; ++m) {
                const size_t off = (size_t)(u.pm * BM + ai * HALF + wr * 64 + m * 16 + fr) * DM + u.pn * BM + wc * 32 + 4 * fq;
#pragma unroll
                for (int bj = 0; bj < 2; ++bj)
#pragma unroll
                    for (int n = 0; n < 2; ++n) *(f32x4*)(out + off + bj * HALF + n * 16) = rr[m][bj][n] * ALPHA + acc[ai][bj][m][n];
            }
        }
    }
};
struct EpiUp {
    static constexpr bool PERM = true;
    bf16* H;
    __device__ __forceinline__ void operator()(AccRef acc, const Unit& u, int wr, int wc, int fr, int fq) const {
#pragma unroll
        for (int ai = 0; ai < 2; ++ai)
#pragma unroll
            for (int m = 0; m < 4; ++m) {
                asm volatile("" ::: "memory");
                const int row = u.pm * BM + ai * HALF + wr * 64 + m * 16 + fr;
#pragma unroll
                for (int bj = 0; bj < 2; ++bj) { const int col = u.pn * BM + bj * HALF + wc * 32 + 8 * fq;
                    f32x4 v0 = acc[ai][bj][m][0], v1 = acc[ai][bj][m][1];
#pragma unroll
                    for (int e = 0; e < 4; ++e) { const float a = fmaxf(v0[e], 0.f), b = fmaxf(v1[e], 0.f); v0[e] = a * a; v1[e] = b * b; }
                    st_bf16x8(H + (size_t)row * DFF + col, v0, v1); }
            }
    }
};
struct EpiBig {
    static constexpr bool PERM = true;
    bf16* R; bf16* Kk; bf16* V; bf16* L;
    __device__ __forceinline__ void operator()(AccRef acc, const Unit& u, int wr, int wc, int fr, int fq) const {
        const int pn = u.pn;
        bf16* r_ = R; bf16* k_ = Kk; bf16* v_ = V; bf16* l_ = L;
        asm volatile("" : "+s"(r_), "+s"(k_), "+s"(v_), "+s"(l_));
        bf16* base = r_; if (pn >= 4) base = k_; if (pn >= 8) base = v_;
#pragma unroll
        for (int ai = 0; ai < 2; ++ai)
#pragma unroll
            for (int m = 0; m < 4; ++m) {
                asm volatile("" ::: "memory");
                const int row = u.pm * BM + ai * HALF + wr * 64 + m * 16 + fr;
#pragma unroll
                for (int bj = 0; bj < 2; ++bj) {
                    const int cl = bj * HALF + wc * 32 + 8 * fq;
                    f32x4 v0 = acc[ai][bj][m][0], v1 = acc[ai][bj][m][1];
                    bf16* p;
                    if (pn < 12) { p = base + (size_t)row * DM + (pn & 3) * BM + cl; }
                    else if (pn == 12) { p = l_ + (size_t)row * 512 + cl;
                        if (bj == 0) {
#pragma unroll
                            for (int e = 0; e < 4; ++e) { v0[e] = 1.0f - 2.0f * __builtin_amdgcn_rcpf(__builtin_amdgcn_exp2f(2.8853900817779268f * v0[e]) + 1.0f); v1[e] = 1.0f - 2.0f * __builtin_amdgcn_rcpf(__builtin_amdgcn_exp2f(2.8853900817779268f * v1[e]) + 1.0f); } } }
                    else { p = l_ + (size_t)row * 512 + 256 + cl;
#pragma unroll
                        for (int e = 0; e < 4; ++e) { v0[e] = sigmoidf_(v0[e]); v1[e] = sigmoidf_(v1[e]); } }
                    st_bf16x8(p, v0, v1);
                }
            }
    }
};
struct EpiPlain {
    static constexpr bool PERM = true;
    bf16* O; int ldc;
    __device__ __forceinline__ void operator()(AccRef acc, const Unit& u, int wr, int wc, int fr, int fq) const {
#pragma unroll
        for (int ai = 0; ai < 2; ++ai)
#pragma unroll
            for (int m = 0; m < 4; ++m) {
                asm volatile("" ::: "memory");
                const int row = u.pm * BM + ai * HALF + wr * 64 + m * 16 + fr;
#pragma unroll
                for (int bj = 0; bj < 2; ++bj) { const int col = u.pn * BM + bj * HALF + wc * 32 + 8 * fq; st_bf16x8(O + (size_t)row * ldc + col, acc[ai][bj][m][0], acc[ai][bj][m][1]); }
            }
    }
};
__device__ __forceinline__ void epi_dispatch(const GemmDesc& d, AccRef acc, const Unit& u, int wr, int wc, int fr, int fq) {
    switch (d.mode) {
    case 0: { EpiP1 E{(bf16*)d.p0, (bf16*)d.p1, (bf16*)d.p2, (float*)d.p3, (const float*)d.p4, d.i0}; E(acc, u, wr, wc, fr, fq); } break;
    case 1: { EpiQ E{(bf16*)d.p0, (const float*)d.p3, (const float*)d.p4, d.i0}; E(acc, u, wr, wc, fr, fq); } break;
    case 2: { EpiKn E{(bf16*)d.p0, (const float*)d.p3}; E(acc, u, wr, wc, fr, fq); } break;
    case 3: { EpiVt E{(bf16*)d.p0, (const float*)d.p3}; E(acc, u, wr, wc, fr, fq); } break;
    case 4: { EpiRes E{(const float*)d.p1, (float*)d.p0}; E(acc, u, wr, wc, fr, fq); } break;
    case 5: { EpiUp E{(bf16*)d.p0}; E(acc, u, wr, wc, fr, fq); } break;
    case 6: { EpiBig E{(bf16*)d.p0, (bf16*)d.p1, (bf16*)d.p2, (bf16*)d.p3}; E(acc, u, wr, wc, fr, fq); } break;
    case 8: break;
    default: { EpiPlain E{(bf16*)d.p0, d.i0}; E(acc, u, wr, wc, fr, fq); } break;
    }
}
constexpr unsigned CW_SEAM = 16384, SEAM_BANK = 64 * 64;
constexpr size_t XBUF_OFF = 256 * 1024;
__device__ __forceinline__ void panel_stats(const f32x4 (&v)[2][2][4][2], const Unit& u, int wr, int wc, int fr, int fq, LAS unsigned char* lds, int wid, int lane, unsigned long long* xbuf, unsigned* cnt, float eps) {
    LAS f32x2* Pl = (LAS f32x2*)lds; LAS f32x2* Sl = (LAS f32x2*)(lds + 8192);
#pragma unroll
    for (int ai = 0; ai < 2; ++ai)
#pragma unroll
        for (int m = 0; m < 4; ++m) {
            float s = 0.f;
#pragma unroll
            for (int bj = 0; bj < 2; ++bj)
#pragma unroll
                for (int n = 0; n < 2; ++n) { const f32x4 x = v[ai][bj][m][n]; s += (x[0] + x[1]) + (x[2] + x[3]); }
            s += __shfl_xor(s, 16); s += __shfl_xor(s, 32);
            const float mw = s * (1.0f / 64.0f); float q = 0.f;
#pragma unroll
            for (int bj = 0; bj < 2; ++bj)
#pragma unroll
                for (int n = 0; n < 2; ++n) { const f32x4 dd = v[ai][bj][m][n] - mw; q += (dd[0] * dd[0] + dd[1] * dd[1]) + (dd[2] * dd[2] + dd[3] * dd[3]); }
            q += __shfl_xor(q, 16); q += __shfl_xor(q, 32);
            if (fq == 0) Pl[(ai * HALF + wr * 64 + m * 16 + fr) * 4 + wc] = (f32x2){mw, q};
            __builtin_amdgcn_sched_barrier(0);
        }
    asm volatile("s_waitcnt lgkmcnt(0)" ::: "memory"); __builtin_amdgcn_s_barrier(); asm volatile("" ::: "memory");
    const int row = wid * 32 + (lane & 31);
    if (lane < 32) {
        const f32x2 a = Pl[row * 4 + 0], b = Pl[row * 4 + 1], c = Pl[row * 4 + 2], dd = Pl[row * 4 + 3];
        const float mt = (a[0] + b[0] + c[0] + dd[0]) * 0.25f;
        const float da = a[0] - mt, db = b[0] - mt, dc = c[0] - mt, de = dd[0] - mt;
        const float m2 = (a[1] + b[1]) + (c[1] + dd[1]) + 64.0f * ((da * da + db * db) + (dc * dc + de * de));
        unsigned long long* slot = xbuf + ((size_t)(u.pm * BM + row) * 4 + u.pn);
        __hip_atomic_store(slot, ((unsigned long long)__builtin_bit_cast(unsigned, m2) << 32) | __builtin_bit_cast(unsigned, mt), __ATOMIC_RELAXED, __HIP_MEMORY_SCOPE_AGENT);
    }
    asm volatile("s_waitcnt vmcnt(0)" ::: "memory");
    if (lane == 0) __hip_atomic_fetch_add(cnt + 64 * u.pm, 1u, __ATOMIC_RELAXED, __HIP_MEMORY_SCOPE_AGENT);
    if (wid == 0) {
        for (unsigned sp = 0; sp < (1u << 22); ++sp) {
            if ((unsigned)__builtin_amdgcn_readfirstlane(__hip_atomic_load(cnt + 64 * u.pm, __ATOMIC_RELAXED, __HIP_MEMORY_SCOPE_AGENT)) >= 32u) break;
            __builtin_amdgcn_s_sleep(2);
        }
        __builtin_amdgcn_fence(__ATOMIC_ACQUIRE, "agent");
    }
    asm volatile("s_waitcnt vmcnt(0) lgkmcnt(0)" ::: "memory"); __builtin_amdgcn_s_barrier(); asm volatile("" ::: "memory");
    if (lane < 32) {
        const unsigned long long* slot = xbuf + (size_t)(u.pm * BM + row) * 4; float mt[4], m2[4]; float ms = 0.f;
#pragma unroll
        for (int t = 0; t < 4; ++t) { const unsigned long long w = __hip_atomic_load(slot + t, __ATOMIC_RELAXED, __HIP_MEMORY_SCOPE_AGENT); mt[t] = __builtin_bit_cast(float, (unsigned)w); m2[t] = __builtin_bit_cast(float, (unsigned)(w >> 32)); ms += mt[t]; }
        const float mean = ms * 0.25f; float q = 0.f;
#pragma unroll
        for (int t = 0; t < 4; ++t) { const float dm = mt[t] - mean; q += m2[t] + 256.0f * dm * dm; }
        Sl[row] = (f32x2){mean, 1.0f / sqrtf(q * (1.0f / 1024.0f) + eps)};
    }
    asm volatile("s_waitcnt lgkmcnt(0)" ::: "memory"); __builtin_amdgcn_s_barrier(); asm volatile("" ::: "memory");
}
__device__ __forceinline__ void fused_ln(const GemmDesc& d, f32x4 (&acc)[2][2][4][2], const Unit& u, int wr, int wc, int fr, int fq, LAS unsigned char* lds, int wid, int lane, unsigned char* ws) {
    const float* res = (const float*)d.p1; float* out = (float*)d.p0; const float* g = (const float*)d.p2; const float* b = (const float*)d.p3; bf16* xb = (bf16*)d.p4;
    const int col0 = u.pn * BM + wc * 32 + 4 * fq;
#pragma unroll
    for (int ai = 0; ai < 2; ++ai) {
        f32x4 rr[4][2][2];
#pragma unroll
        for (int m = 0; m < 4; ++m) {
            const size_t off = (size_t)(u.pm * BM + ai * HALF + wr * 64 + m * 16 + fr) * DM + col0;
#pragma unroll
            for (int bj = 0; bj < 2; ++bj)
#pragma unroll
                for (int n = 0; n < 2; ++n) rr[m][bj][n] = *(const f32x4*)(res + off + bj * HALF + n * 16);
        }
#pragma unroll
        for (int m = 0; m < 4; ++m) {
#pragma unroll
            for (int bj = 0; bj < 2; ++bj)
#pragma unroll
                for (int n = 0; n < 2; ++n) acc[ai][bj][m][n] = rr[m][bj][n] * ALPHA + acc[ai][bj][m][n];
            asm volatile("" : "+v"(acc[ai][0][m][0]), "+v"(acc[ai][0][m][1]), "+v"(acc[ai][1][m][0]), "+v"(acc[ai][1][m][1]));
        }
        asm volatile("" ::: "memory"); __builtin_amdgcn_sched_barrier(0);
    }
    panel_stats(acc, u, wr, wc, fr, fq, lds, wid, lane, (unsigned long long*)(ws + XBUF_OFF), (unsigned*)ws + CW_SEAM + (unsigned)d.i0 * SEAM_BANK, LN_EPS);
    const LAS f32x2* Sl = (const LAS f32x2*)(lds + 8192);
    int fr2 = fr, fq2 = fq; asm volatile("" : "+v"(fr2), "+v"(fq2));
    asm volatile("" : "+s"(g), "+s"(b), "+s"(out), "+s"(xb));
    const int col0b = u.pn * BM + wc * 32 + 4 * fq2;
#pragma unroll
    for (int ai = 0; ai < 2; ++ai)
#pragma unroll
        for (int m = 0; m < 4; ++m) {
            const int r = ai * HALF + wr * 64 + m * 16 + fr2; const f32x2 sr = Sl[r];
            const size_t off = (size_t)(u.pm * BM + r) * DM + col0b;
#pragma unroll
            for (int bj = 0; bj < 2; ++bj)
#pragma unroll
                for (int n = 0; n < 2; ++n) {
                    const f32x4 gg = *(const f32x4*)(g + col0b + bj * HALF + n * 16), bb = *(const f32x4*)(b + col0b + bj * HALF + n * 16);
                    const f32x4 o = (acc[ai][bj][m][n] - sr[0]) * sr[1] * gg + bb;
                    *(f32x4*)(out + off + bj * HALF + n * 16) = o;
                    if (xb) st_bf16x4(xb + off + bj * HALF + n * 16, o);
                }
            asm volatile("" ::: "memory"); __builtin_amdgcn_sched_barrier(0);
        }
}
}

__device__ __forceinline__ void p0_item(const Job& J, int item, LAS float* scr, int lane) {
    const int kb = item / J.nnb, nb = item % J.nnb, k0 = 64 * kb;
    const int scol = J.col0 + (nb / J.cpb) * J.cstride + (nb % J.cpb) * 32;
    float vals[32];
    const int kmax = J.Ksrc - 1, hk = lane >> 5, ln = lane & 31;
    const float* sp = J.src + scol + ln;
#pragma unroll
    for (int i = 0; i < 32; ++i) { const int k = k0 + 2 * i + hk; const int kc = k < kmax ? k : kmax; vals[i] = sp[(size_t)kc * J.ld_src]; }
    if (J.ksc) {
#pragma unroll
        for (int i = 0; i < 32; ++i) { const int k = k0 + 2 * i + hk; const int kc = k < kmax ? k : kmax; vals[i] *= J.ksc[kc]; }
    }
#pragma unroll
    for (int i = 0; i < 32; ++i) { const int kk = 2 * i + hk; scr[kk * 33 + ln] = (k0 + kk <= kmax) ? vals[i] : 0.f; }
    asm volatile("s_waitcnt lgkmcnt(0)" ::: "memory");
    const int c = lane & 7;
#pragma unroll
    for (int j = 0; j < 4; ++j) { const int n = (lane >> 3) + 8 * j; const LAS float* s = scr + (8 * c) * 33 + n;
        u32x4 o; o.x = cvtpk(s[0 * 33], s[1 * 33]); o.y = cvtpk(s[2 * 33], s[3 * 33]); o.z = cvtpk(s[4 * 33], s[5 * 33]); o.w = cvtpk(s[6 * 33], s[7 * 33]);
        *(u32x4*)(J.dst + (size_t)(J.row0 + nb * 32 + n) * J.ld_dst + J.kcol0 + k0 + 8 * c) = o; }
    asm volatile("s_waitcnt lgkmcnt(0)" ::: "memory");
}
__constant__ float ROPE_HI[16] = {1.591549367e-01f, 8.949939907e-02f, 5.032921210e-02f, 2.830219641e-02f, 1.591549441e-02f, 8.949940093e-03f, 5.032921210e-03f, 2.830219688e-03f, 1.591549488e-03f, 8.949940093e-04f, 5.032921326e-04f, 2.830219455e-04f, 1.591549371e-04f, 8.949940093e-05f, 5.032921035e-05f, 2.830219637e-05f};
__constant__ float ROPE_LO[16] = {6.420638243e-09f, 2.542919653e-09f, 5.173299289e-12f, -5.826552019e-10f, -1.029942243e-10f, 6.802745173e-11f, 5.173301024e-13f, -1.048316434e-10f, -5.686555046e-11f, 6.802744999e-12f, -1.158979943e-11f, 1.279990003e-11f, 5.954976963e-12f, 6.802745216e-13f, 1.751403167e-12f, -5.389994549e-13f};

namespace attn {
constexpr int KSTR = 208, VSTR = 136;
constexpr int KBYTES = 64 * KSTR, VBYTES = 64 * VSTR, BUFB = KBYTES + VBYTES;
constexpr int OST_OFF = 45056, OST_WAVE = 32 * 144;
__device__ __forceinline__ int crow(int r, int hi) { return (r & 3) + 8 * (r >> 2) + 4 * hi; }

__device__ __forceinline__ void unit(LAS unsigned char* lds, const bf16* __restrict__ Q, const bf16* __restrict__ Kn, const bf16* __restrict__ Kr, const bf16* __restrict__ Vt, bf16* __restrict__ O,
                                     int tokbase, int S, int h, int qb, const int tid) {
    const int lane = tid & 63, r32 = lane & 31, hi = lane >> 5, wid = __builtin_amdgcn_readfirstlane(tid >> 6);
    const int NT = S / 64;
    const int qrow = tokbase + qb * 256 + wid * 32 + r32;
    bf16x8 qf[6];
#pragma unroll
    for (int d0 = 0; d0 < 6; ++d0) qf[d0] = *(const bf16x8*)(Q + (size_t)qrow * 1536 + h * 96 + d0 * 16 + hi * 8);
    const int kkey = tid >> 3, kch = tid & 7;
    const int rkey = (tid & 255) >> 2, rch = tid & 3;
    const int vd = tid >> 3, vch = tid & 7;
    const bf16* kp = Kn + (size_t)(tokbase + kkey) * 1024 + h * 64 + kch * 8;
    const bf16* rp = Kr + (size_t)(tokbase + rkey) * 32 + rch * 8;
    const bf16* vp = Vt + (size_t)(h * 64 + vd) * MH + tokbase + vch * 8;
    u32x4 kreg, rreg = {0, 0, 0, 0}, vreg;
    kreg = *(const u32x4*)kp; if (tid < 256) rreg = *(const u32x4*)rp; vreg = *(const u32x4*)vp;
#define ATT_WRITE(buf) do { LAS unsigned char* b_ = lds + (buf) * BUFB; \
        *(LAS u32x4*)(b_ + kkey * KSTR + kch * 16) = kreg; \
        if (tid < 256) *(LAS u32x4*)(b_ + rkey * KSTR + 128 + rch * 16) = rreg; \
        *(LAS u32x2*)(b_ + KBYTES + vd * VSTR + vch * 16) = (u32x2){vreg.x, vreg.y}; \
        *(LAS u32x2*)(b_ + KBYTES + vd * VSTR + vch * 16 + 8) = (u32x2){vreg.z, vreg.w}; } while (0)
    ATT_WRITE(0);
    __syncthreads();
    float mref = 0.f, l_run = 0.f;
    f32x16 o0 = {}, o1 = {};
#define MAX3(a, b, c) ({ float r_; asm("v_max3_f32 %0, %1, %2, %3" : "=v"(r_) : "v"(a), "v"(b), "v"(c)); r_; })
    for (int t = 0; t < NT; ++t) {
        if (t + 1 < NT) {
            kreg = *(const u32x4*)(kp + (size_t)(t + 1) * 64 * 1024);
            if (tid < 256) rreg = *(const u32x4*)(rp + (size_t)(t + 1) * 64 * 32);
            vreg = *(const u32x4*)(vp + (size_t)(t + 1) * 64);
        }
        const LAS unsigned char* kb = lds + (t & 1) * BUFB;
        const LAS unsigned char* vb = kb + KBYTES;
        f32x16 p0 = {}, p1 = {};
        {
            bf16x8 kf0[6], kf1[6];
#pragma unroll
            for (int d0 = 0; d0 < 6; ++d0) { kf0[d0] = *(const LAS bf16x8*)(kb + r32 * KSTR + d0 * 32 + hi * 16); kf1[d0] = *(const LAS bf16x8*)(kb + (32 + r32) * KSTR + d0 * 32 + hi * 16); }
            __builtin_amdgcn_sched_barrier(0);
#pragma unroll
            for (int d0 = 0; d0 < 6; ++d0) { p0 = __builtin_amdgcn_mfma_f32_32x32x16_bf16(kf0[d0], qf[d0], p0, 0, 0, 0); p1 = __builtin_amdgcn_mfma_f32_32x32x16_bf16(kf1[d0], qf[d0], p1, 0, 0, 0); }
        }
        float mx = MAX3(p0[0], p0[1], p0[2]);
        mx = MAX3(mx, p0[3], p0[4]); mx = MAX3(mx, p0[5], p0[6]); mx = MAX3(mx, p0[7], p0[8]); mx = MAX3(mx, p0[9], p0[10]); mx = MAX3(mx, p0[11], p0[12]);
        mx = MAX3(mx, p0[13], p0[14]); mx = MAX3(mx, p0[15], p1[0]); mx = MAX3(mx, p1[1], p1[2]); mx = MAX3(mx, p1[3], p1[4]); mx = MAX3(mx, p1[5], p1[6]);
        mx = MAX3(mx, p1[7], p1[8]); mx = MAX3(mx, p1[9], p1[10]); mx = MAX3(mx, p1[11], p1[12]); mx = MAX3(mx, p1[13], p1[14]); mx = MAX3(mx, p1[15], p1[15]);
        { const float mo = __shfl_xor(mx, 32); mx = MAX3(mx, mo, mo); }
        if (__any(mx - mref > 8.0f)) {
            const float dl = fmaxf(mx - mref, 0.f);
            mref += dl;
            const float alpha = __builtin_amdgcn_exp2f(-dl);
            l_run *= alpha;
#pragma unroll
            for (int r = 0; r < 16; ++r) { o0[r] *= alpha; o1[r] *= alpha; }
        }
        if (__any(mref != 0.f)) {
            float la = 0.f, lb = 0.f, lc = 0.f, ld = 0.f;
#pragma unroll
            for (int r = 0; r < 16; r += 2) { p0[r] = __builtin_amdgcn_exp2f(p0[r] - mref); p1[r] = __builtin_amdgcn_exp2f(p1[r] - mref); p0[r + 1] = __builtin_amdgcn_exp2f(p0[r + 1] - mref); p1[r + 1] = __builtin_amdgcn_exp2f(p1[r + 1] - mref);
                la += p0[r]; lb += p1[r]; lc += p0[r + 1]; ld += p1[r + 1]; }
            l_run += (la + lb) + (lc + ld);
        } else {
            float la = 0.f, lb = 0.f, lc = 0.f, ld = 0.f;
#pragma unroll
            for (int r = 0; r < 16; r += 2) { p0[r] = __builtin_amdgcn_exp2f(p0[r]); p1[r] = __builtin_amdgcn_exp2f(p1[r]); p0[r + 1] = __builtin_amdgcn_exp2f(p0[r + 1]); p1[r + 1] = __builtin_amdgcn_exp2f(p1[r + 1]);
                la += p0[r]; lb += p1[r]; lc += p0[r + 1]; ld += p1[r + 1]; }
            l_run += (la + lb) + (lc + ld);
        }
        bf16x8 pb[2][2];
#pragma unroll
        for (int s = 0; s < 2; ++s) {
            u32x4 w0 = {cvtpk(p0[8 * s + 0], p0[8 * s + 1]), cvtpk(p0[8 * s + 2], p0[8 * s + 3]), cvtpk(p0[8 * s + 4], p0[8 * s + 5]), cvtpk(p0[8 * s + 6], p0[8 * s + 7])};
            u32x4 w1 = {cvtpk(p1[8 * s + 0], p1[8 * s + 1]), cvtpk(p1[8 * s + 2], p1[8 * s + 3]), cvtpk(p1[8 * s + 4], p1[8 * s + 5]), cvtpk(p1[8 * s + 6], p1[8 * s + 7])};
            pb[0][s] = __builtin_bit_cast(bf16x8, w0); pb[1][s] = __builtin_bit_cast(bf16x8, w1);
        }
        {
            bf16x8 vfa[2][2], vfb[2][2];
#pragma unroll
            for (int kt = 0; kt < 2; ++kt)
#pragma unroll
                for (int s = 0; s < 2; ++s) {
                    const int kcol = (kt * 32 + 16 * s + 4 * hi) * 2;
                    const u32x2 a0 = *(const LAS u32x2*)(vb + r32 * VSTR + kcol), a1 = *(const LAS u32x2*)(vb + r32 * VSTR + kcol + 16);
                    const u32x2 b0 = *(const LAS u32x2*)(vb + (32 + r32) * VSTR + kcol), b1 = *(const LAS u32x2*)(vb + (32 + r32) * VSTR + kcol + 16);
                    vfa[kt][s] = __builtin_bit_cast(bf16x8, (u32x4){a0.x, a0.y, a1.x, a1.y});
                    vfb[kt][s] = __builtin_bit_cast(bf16x8, (u32x4){b0.x, b0.y, b1.x, b1.y});
                }
            __builtin_amdgcn_sched_barrier(0);
#pragma unroll
            for (int kt = 0; kt < 2; ++kt)
#pragma unroll
                for (int s = 0; s < 2; ++s) {
                    o0 = __builtin_amdgcn_mfma_f32_32x32x16_bf16(vfa[kt][s], pb[kt][s], o0, 0, 0, 0);
                    o1 = __builtin_amdgcn_mfma_f32_32x32x16_bf16(vfb[kt][s], pb[kt][s], o1, 0, 0, 0);
                }
        }
        if (t + 1 < NT) ATT_WRITE((t + 1) & 1);
        __syncthreads();
    }
#undef ATT_WRITE
    l_run += __shfl_xor(l_run, 32);
    const float inv = 1.0f / l_run;
    LAS unsigned char* stg = lds + OST_OFF + wid * OST_WAVE;
#pragma unroll
    for (int r = 0; r < 16; ++r) { const int d = crow(r, hi);
        *(LAS bf16*)(stg + r32 * 144 + d * 2) = f2bf(o0[r] * inv);
        *(LAS bf16*)(stg + r32 * 144 + (32 + d) * 2) = f2bf(o1[r] * inv); }
    asm volatile("s_waitcnt lgkmcnt(0)" ::: "memory");
    bf16* Ow = O + (size_t)(tokbase + qb * 256 + wid * 32) * 1024 + h * 64;
#pragma unroll
    for (int i = 0; i < 4; ++i) { const int row = i * 8 + (lane >> 3), ch = lane & 7; const u32x4 v = *(const LAS u32x4*)(stg + row * 144 + ch * 16); *(u32x4*)(Ow + (size_t)row * 1024 + ch * 8) = v; }
    __syncthreads();
}
}

__device__ __forceinline__ void ln_regs(f32x4 (&v)[4], const float* g, const float* b, int lane) {
    float s = 0.f;
#pragma unroll
    for (int j = 0; j < 4; ++j) s += (v[j][0] + v[j][1]) + (v[j][2] + v[j][3]);
    const float mean = wave_sum(s) * (1.0f / DM); float s2 = 0.f;
#pragma unroll
    for (int j = 0; j < 4; ++j) { v[j] = v[j] - mean; s2 += (v[j][0] * v[j][0] + v[j][1] * v[j][1]) + (v[j][2] * v[j][2] + v[j][3] * v[j][3]); }
    const float rstd = __builtin_amdgcn_rsqf(wave_sum(s2) * (1.0f / DM) + LN_EPS);
#pragma unroll
    for (int j = 0; j < 4; ++j) { const f32x4 gg = *(const f32x4*)(g + 256 * j + 4 * lane), bb = *(const f32x4*)(b + 256 * j + 4 * lane); v[j] = v[j] * rstd * gg + bb; }
}
__device__ __forceinline__ void ld_row(f32x4 (&v)[4], const float* p, int lane) {
#pragma unroll
    for (int j = 0; j < 4; ++j) v[j] = *(const f32x4*)(p + 256 * j + 4 * lane);
}
__device__ __forceinline__ void st_row(const f32x4 (&v)[4], float* p, int lane) {
#pragma unroll
    for (int j = 0; j < 4; ++j) *(f32x4*)(p + 256 * j + 4 * lane) = v[j];
}
__device__ __forceinline__ void st_row_bf16(const f32x4 (&v)[4], bf16* p, int lane) {
#pragma unroll
    for (int j = 0; j < 4; ++j) pg8::st_bf16x4(p + 256 * j + 4 * lane, v[j]);
}

namespace scan {
constexpr int T = 32, SSTR = 400;
constexpr int BUF_FLOATS = T * SSTR;
constexpr int WB_OFF = 2 * BUF_FLOATS * 4;
constexpr int WB_STR = 144;

struct Prob { int e, h, tokbase, S, row0; };
struct PrepRegs { bf16x8 twA[2], alA[2]; u32x2 kx[4], rx[4], vx[4]; };

__device__ __forceinline__ int tok_of(const Prob& P, int tau) { return P.tokbase + (P.e ? (P.S - 1 - tau) : tau); }
__device__ __forceinline__ float xsum4(float v) { v += __shfl_xor(v, 16); v += __shfl_xor(v, 32); return v; }
__device__ __forceinline__ f32x4 bf4(u32x2 v) { return (f32x4){__builtin_bit_cast(float, v.x << 16), __builtin_bit_cast(float, v.x & 0xffff0000u), __builtin_bit_cast(float, v.y << 16), __builtin_bit_cast(float, v.y & 0xffff0000u)}; }

__device__ __forceinline__ void prep_load(PrepRegs& R, const Prob& P, int c, int st0, int lane,
                                          const bf16* __restrict__ Rb, const bf16* __restrict__ Kb, const bf16* __restrict__ Vb, const bf16* __restrict__ Lb) {
    const int c16 = lane & 15, q = lane >> 4;
    const int tok = tok_of(P, c * T + st0 + c16);
#pragma unroll
    for (int ks = 0; ks < 2; ++ks) {
        R.twA[ks] = *(const bf16x8*)(Lb + (size_t)tok * 512 + P.e * 64 + ks * 32 + 8 * q);
        R.alA[ks] = *(const bf16x8*)(Lb + (size_t)tok * 512 + 128 + P.e * 64 + ks * 32 + 8 * q);
    }
    const size_t o = (size_t)tok * DM + P.h * 64 + 4 * q;
#pragma unroll
    for (int nt = 0; nt < 4; ++nt) { R.kx[nt] = *(const u32x2*)(Kb + o + nt * 16); R.rx[nt] = *(const u32x2*)(Rb + o + nt * 16); R.vx[nt] = *(const u32x2*)(Vb + o + nt * 16); }
}
__device__ __forceinline__ void prep_compute(LAS float* buf, LAS unsigned char* wlds, const PrepRegs& R, const Prob& P, int c, int st0, int lane, float* coef) {
    const int c16 = lane & 15, q = lane >> 4;
    const LAS float* cst = (const LAS float*)(wlds + 2 * 64 * WB_STR) + 4 * q;
    const LAS unsigned char* wfr = wlds + c16 * WB_STR + q * 16;
    asm volatile("" : "+v"(cst), "+v"(wfr));
    f32x4 accw[4], acca[4];
#pragma unroll
    for (int nt = 0; nt < 4; ++nt) {
        accw[nt] = (f32x4){0.f, 0.f, 0.f, 0.f}; acca[nt] = (f32x4){0.f, 0.f, 0.f, 0.f};
#pragma unroll
        for (int ks = 0; ks < 2; ++ks) {
            const bf16x8 wB = *(const LAS bf16x8*)(wfr + nt * 16 * WB_STR + ks * 64);
            const bf16x8 aB = *(const LAS bf16x8*)(wfr + 64 * WB_STR + nt * 16 * WB_STR + ks * 64);
            accw[nt] = __builtin_amdgcn_mfma_f32_16x16x32_bf16(wB, R.twA[ks], accw[nt], 0, 0, 0);
            acca[nt] = __builtin_amdgcn_mfma_f32_16x16x32_bf16(aB, R.alA[ks], acca[nt], 0, 0, 0);
        }
    }
    const int st = st0 + c16;
    const int tok = tok_of(P, c * T + st);
    LAS float* rec = buf + st * SSTR + 4 * q;
    asm volatile("" : "+v"(rec));
    f32x4 kf[4], rf[4], av[4], kkr[4];
    float ss = 0.f;
#pragma unroll
    for (int nt = 0; nt < 4; ++nt) {
        const int ch0 = nt * 16;
        const f32x4 a0v = *(const LAS f32x4*)(cst + 64 + ch0), kkv = *(const LAS f32x4*)(cst + 128 + ch0);
        kf[nt] = bf4(R.kx[nt]); rf[nt] = bf4(R.rx[nt]);
#pragma unroll
        for (int e = 0; e < 4; ++e) { av[nt][e] = sigmoidf_(a0v[e] + acca[nt][e]); kkr[nt][e] = kf[nt][e] * kkv[e]; ss += kkr[nt][e] * kkr[nt][e]; }
    }
    ss = xsum4(ss);
    const float inv = __builtin_amdgcn_rsqf(fmaxf(ss, 1e-24f));
    float cf = 0.f, br = 0.f, kr = 0.f;
#pragma unroll
    for (int nt = 0; nt < 4; ++nt) {
        const int ch0 = nt * 16;
        const f32x4 w0v = *(const LAS f32x4*)(cst + ch0), kav = *(const LAS f32x4*)(cst + 192 + ch0), rkv = *(const LAS f32x4*)(cst + 256 + ch0);
        f32x4 nk, wv, bv, kdv, wrv;
#pragma unroll
        for (int e = 0; e < 4; ++e) {
            const float u = sigmoidf_(w0v[e] + accw[nt][e]);
            const float w = __builtin_amdgcn_exp2f(-0.8750387749145276f * u);
            const float kk = kkr[nt][e] * inv;
            const float kd = kf[nt][e] * (1.0f + (av[nt][e] - 1.0f) * kav[e]);
            const float b = kk * av[nt][e];
            cf += rf[nt][e] * kd * rkv[e]; br += b * rf[nt][e]; kr += kd * rf[nt][e];
            nk[e] = -kk; wv[e] = w; bv[e] = b; kdv[e] = kd; wrv[e] = w * rf[nt][e];
        }
        *(LAS f32x4*)(rec + ch0) = nk; *(LAS f32x4*)(rec + 64 + ch0) = wv; *(LAS f32x4*)(rec + 128 + ch0) = bv; *(LAS f32x4*)(rec + 192 + ch0) = kdv; *(LAS f32x4*)(rec + 256 + ch0) = wrv;
        *(LAS f32x4*)(rec + 320 + ch0) = bf4(R.vx[nt]);
    }
    cf = xsum4(cf); br = xsum4(br); kr = xsum4(kr);
    if (q == 0) { coef[((size_t)P.e * MH + tok) * NH + P.h] = cf; *(LAS f32x2*)(rec + 384) = (f32x2){br, kr};     }
}

template <int L, int NSW, int PW0, int NPAIR, int PD>
__device__ __forceinline__ void run(LAS unsigned char* lds, const Prob& P, const bf16* Rb, const bf16* Kb, const bf16* Vb, const bf16* Lb, const bf16* w2t, const bf16* a2t,
                                    const float* w0, const float* a0, const float* k_k, const float* k_a, const float* r_k, bf16* Yb, float* coef, const int tid_in, const int pm) {
    constexpr int EPL = 64 / L, RPW = 64 / L, NG = EPL / 4;
    int tid = tid_in; asm volatile("" : "+v"(tid));
    const int lane = tid & 63, wid = __builtin_amdgcn_readfirstlane(tid >> 6);
    LAS float* bufs = (LAS float*)lds;
    LAS unsigned char* wlds = lds + WB_OFF;
    const bool is_prep = (wid >= PW0 && wid < PW0 + 2 * NPAIR);
    const int pw = wid - PW0, st0 = (pw & 1) * 16;
    for (int i = tid; i < 2 * 64 * 8; i += 512) {
        const int m = i >> 9, chn = (i >> 3) & 63, kc = i & 7;
        const bf16* src = (m ? a2t : w2t) + ((size_t)P.e * 1024 + P.h * 64 + chn) * 64 + kc * 8;
        *(LAS u32x4*)(wlds + m * 64 * WB_STR + chn * WB_STR + kc * 16) = *(const u32x4*)src;
    }
    { LAS float* cstw = (LAS float*)(wlds + 2 * 64 * WB_STR); const int hch = P.h * 64 + lane;
      if (wid == 0) cstw[lane] = w0[P.e * 1024 + hch];
      if (wid == 1) cstw[64 + lane] = a0[P.e * 1024 + hch];
      if (wid == 2) cstw[128 + lane] = k_k[hch];
      if (wid == 3) cstw[192 + lane] = k_a[hch];
      if (wid == 4) cstw[256 + lane] = r_k[hch]; }
    const int NC = P.S / T;
    PrepRegs R;
    int lc = pw >> 1;
    if (is_prep) prep_load(R, P, lc, st0, lane, Rb, Kb, Vb, Lb);
    __syncthreads();
    if (is_prep && lc == 0) { prep_compute(bufs, wlds, R, P, 0, st0, lane, coef); lc += NPAIR; if (lc < NC) prep_load(R, P, lc, st0, lane, Rb, Kb, Vb, Lb); }
    __syncthreads();
    const int s = lane & (L - 1), rloc = lane / L;
    const int row = P.row0 + wid * RPW + rloc;
#define SCAN_BAR() asm volatile("s_waitcnt lgkmcnt(0)\n\ts_barrier" ::: "memory")
    if (is_prep) {
        for (int c = 0; c < NC; ++c) {
            if (lc == c + 1 && lc < NC) {
                if (!(pm & 1)) prep_compute(bufs + ((c + 1) & 1) * BUF_FLOATS, wlds, R, P, c + 1, st0, lane, coef);
                asm volatile("" ::: "memory"); __builtin_amdgcn_sched_barrier(0);
                lc += NPAIR; if (lc < NC) prep_load(R, P, lc, st0, lane, Rb, Kb, Vb, Lb);
                asm volatile("" ::: "memory"); __builtin_amdgcn_sched_barrier(0);
            }
            SCAN_BAR();
        }
    } else {
        float St[EPL];
#pragma unroll
        for (int e = 0; e < EPL; ++e) St[e] = 0.f;
        float ykeep = 0.f;
        for (int c = 0; c < NC; ++c) {
        if (wid < NSW && !(pm & 2)) {
            const LAS float* buf = bufs + (c & 1) * BUF_FLOATS;
            const LAS float* lb = buf + 4 * s; const LAS float* lv = buf + 320 + row;
            asm volatile("" : "+v"(lb), "+v"(lv));
            f32x4 naA[NG], wrA[NG], naB[NG], wrB[NG], w[NG], b[NG], kd[NG]; float vi; f32x2 sc;
#define SCAN_LOAD_NW(NA, WR, st_) do { const LAS float* rec_ = lb + (st_) * SSTR; \
                _Pragma("unroll") for (int g4 = 0; g4 < NG; ++g4) { const int j0 = g4 * (4 * L); NA[g4] = *(const LAS f32x4*)(rec_ + j0); WR[g4] = *(const LAS f32x4*)(rec_ + 256 + j0); } } while (0)
#define SCAN_LOAD_REST(st_) do { const LAS float* rec_ = lb + (st_) * SSTR; \
                _Pragma("unroll") for (int g4 = 0; g4 < NG; ++g4) { const int j0 = g4 * (4 * L); \
                    w[g4] = *(const LAS f32x4*)(rec_ + 64 + j0); b[g4] = *(const LAS f32x4*)(rec_ + 128 + j0); kd[g4] = *(const LAS f32x4*)(rec_ + 192 + j0); } \
                vi = lv[(st_) * SSTR]; sc = *(const LAS f32x2*)(buf + (st_) * SSTR + 384); } while (0)
#define SCAN_STEP(NA, WR, st_) do { \
                f32x2 a1_ = {0.f, 0.f}, a2_ = {0.f, 0.f}; \
                _Pragma("unroll") for (int g4 = 0; g4 < NG; ++g4) _Pragma("unroll") for (int e = 0; e < 4; e += 2) { \
                    const f32x2 s2_ = {St[g4 * 4 + e], St[g4 * 4 + e + 1]}; \
                    a1_ = s2_ * (f32x2){NA[g4][e], NA[g4][e + 1]} + a1_; a2_ = s2_ * (f32x2){WR[g4][e], WR[g4][e + 1]} + a2_; } \
                float d1 = a1_[0] + a1_[1], d2 = a2_[0] + a2_[1]; \
                if (L == 16) { d1 = allred16(d1); d2 = allred16(d2); } else if (L == 8) { d1 = allred8(d1); d2 = allred8(d2); } else { d1 = allred4(d1); d2 = allred4(d2); } \
                const float sa = d1, cv = vi; \
                const float y = d2 + sa * sc[0] + cv * sc[1]; \
                _Pragma("unroll") for (int g4 = 0; g4 < NG; ++g4) _Pragma("unroll") for (int e = 0; e < 4; ++e) St[g4 * 4 + e] = St[g4 * 4 + e] * w[g4][e] + (sa * b[g4][e] + cv * kd[g4][e]); \
                ykeep = (s == ((st_) & (L - 1))) ? y : ykeep; \
                if (((st_) & (L - 1)) == L - 1 && !(pm & 4)) { \
                    const int tok = tok_of(P, c * T + ((st_) - (L - 1)) + s); \
                    Yb[((size_t)P.e * MH + tok) * DM + P.h * 64 + row] = f2bf(ykeep); \
                } } while (0)
            SCAN_LOAD_NW(naA, wrA, 0);
#pragma unroll 1
            for (int st = 0; st < T; st += 2) {
                SCAN_LOAD_REST(st);
                SCAN_LOAD_NW(naB, wrB, st + 1);
                SCAN_STEP(naA, wrA, st);
                __builtin_amdgcn_sched_barrier(0);
                SCAN_LOAD_REST(st + 1);
                if (st + 2 < T) SCAN_LOAD_NW(naA, wrA, st + 2);
                SCAN_STEP(naB, wrB, st + 1);
                __builtin_amdgcn_sched_barrier(0);
            }
#undef SCAN_LOAD_NW
#undef SCAN_LOAD_REST
#undef SCAN_STEP
        }
            SCAN_BAR();
        }
    }
#undef SCAN_BAR
}
}

#define XB_TMO      128
#define XB_XCNT(j)  (256  + 64 * (j))
#define XB_XSUB(j)  (1280 + 64 * (j))
#define XB_XGEN(j)  (2304 + 64 * (j))
#define XB_TOP      3328
#define XB_TOPGEN   3392
#define XCD_BAR_WORDS 3456
#define XB_SPIN_CAP (1u << 22)
__device__ __forceinline__ unsigned xb_ld(unsigned* p)              { return __hip_atomic_load(p, __ATOMIC_RELAXED, __HIP_MEMORY_SCOPE_AGENT); }
__device__ __forceinline__ unsigned xb_add(unsigned* p, unsigned v) { return __hip_atomic_fetch_add(p, v, __ATOMIC_RELAXED, __HIP_MEMORY_SCOPE_AGENT); }
__device__ __forceinline__ unsigned xb_xcc_id() { return (unsigned)__builtin_amdgcn_s_getreg((3 << 11) | 20) & 0xFu; }
#define XB_SPIN(cond, bar) do { unsigned _sp = 0; while (cond) { __builtin_amdgcn_s_sleep(1); \
    if ((++_sp & 255u) == 0u) { if (xb_ld(&(bar)[XB_TMO])) break; if (_sp > XB_SPIN_CAP) { atomicAdd(&(bar)[XB_TMO], 1u); break; } } } } while (0)
__device__ __forceinline__ void xcd_barrier_complete(unsigned* bar, unsigned x, unsigned& nloc, unsigned& nx) {
    const unsigned G = gridDim.x * gridDim.y * gridDim.z;
    unsigned sum, cnt, mine, sp = 0u;
    for (;;) {
        sum = 0u; cnt = 0u; mine = 0u;
#pragma unroll
        for (unsigned j = 0; j < 16; ++j) { const unsigned c = xb_ld(&bar[XB_XCNT(j)]); sum += c; cnt += (c > 0u) ? 1u : 0u; mine = (j == x) ? c : mine; }
        if (sum == G) break;
        __builtin_amdgcn_s_sleep(1);
        if ((++sp & 255u) == 0u) { if (xb_ld(&bar[XB_TMO])) break; if (sp > XB_SPIN_CAP) { atomicAdd(&bar[XB_TMO], 1u); break; } }
    }
    nloc = mine > 0u ? mine : 1u; nx = cnt > 0u ? cnt : 1u;
}
__device__ __forceinline__ void xcd_barrier(unsigned* bar, volatile LAS unsigned* st) {
    asm volatile("s_waitcnt vmcnt(0)" ::: "memory");
    __syncthreads();
    if (threadIdx.x == 0) {
        const unsigned x = xb_xcc_id();
        __builtin_amdgcn_s_waitcnt(0);
        unsigned nloc = st[0], nx = st[1];
        if (nloc == 0u) { xcd_barrier_complete(bar, x, nloc, nx); st[0] = nloc; st[1] = nx; }
        const unsigned old = xb_add(&bar[XB_XSUB(x)], 1u);
        const unsigned gen = old / nloc;
        if (old + 1u == (gen + 1u) * nloc) {
            __builtin_amdgcn_fence(__ATOMIC_RELEASE, "agent");
            asm volatile("s_waitcnt vmcnt(0)" ::: "memory");
            const unsigned og = xb_add(&bar[XB_TOP], 1u);
            const unsigned tg = og / nx;
            if (og + 1u == (tg + 1u) * nx) xb_add(&bar[XB_TOPGEN], 1u);
            else XB_SPIN(xb_ld(&bar[XB_TOPGEN]) == tg, bar);
            __builtin_amdgcn_fence(__ATOMIC_ACQUIRE, "agent");
            xb_add(&bar[XB_XGEN(x)], 1u);
            asm volatile("s_waitcnt vmcnt(0)" ::: "memory");
        } else {
            XB_SPIN(xb_ld(&bar[XB_XGEN(x)]) == gen, bar);
            __builtin_amdgcn_fence(__ATOMIC_ACQUIRE, "agent");
            asm volatile("s_waitcnt vmcnt(0)" ::: "memory");
        }
    }
    __syncthreads();
}

__global__ void __launch_bounds__(512, 2) fwd(Args args_unused) {
    extern __shared__ __attribute__((aligned(16))) unsigned char lds_raw[];
    LAS unsigned char* lds = (LAS unsigned char*)lds_raw;
    typedef pg8::ArgP ArgP;
    const ArgP ap0 = (ArgP)__builtin_amdgcn_kernarg_segment_ptr();
    const int ph_lo = ap0->ph_lo, ph_hi = ap0->ph_hi;
    const int wid0 = __builtin_amdgcn_readfirstlane((int)threadIdx.x >> 6);
    volatile LAS unsigned* bar_st = (volatile LAS unsigned*)(lds + 131072 + 64);
    if (threadIdx.x == 0) { bar_st[0] = 0u; bar_st[1] = 0u; }
    __syncthreads();
    if (ap0->coop && threadIdx.x == 0) (void)xb_add((unsigned*)ap0->ws + XB_XCNT(xb_xcc_id()), 1u);

    int rep_cnt = 0; (void)rep_cnt;
    for (int ph = ph_lo; ph < ph_hi; ++ph) {
        ArgP ap = ap0; asm volatile("" : "+s"(ap));
        int tid; asm volatile("v_mbcnt_lo_u32_b32 %0, -1, 0\n\tv_mbcnt_hi_u32_b32 %0, -1, %0" : "=v"(tid)); tid += wid0 * 64;
        asm volatile("" : "+v"(tid));
#define args (*ap)
        unsigned char* ws = args.ws;
        const bf16* Win_t = (const bf16*)(ws + OFF_WIN); const bf16* Wqb_t = (const bf16*)(ws + OFF_WQB); const bf16* Wk_t = (const bf16*)(ws + OFF_WK); const bf16* Wv_t = (const bf16*)(ws + OFF_WV);
        const bf16* Wo0_t = (const bf16*)(ws + OFF_WO0); const bf16* Wbig_t = (const bf16*)(ws + OFF_WBIG); const bf16* Bg_t = (const bf16*)(ws + OFF_BG); const bf16* Wo1_t = (const bf16*)(ws + OFF_WO1);
        const bf16* w2t = (const bf16*)(ws + OFF_W2T); const bf16* a2t = (const bf16*)(ws + OFF_A2T);
        float* rope = (float*)(ws + OFF_ROPE);
        const int half = ph / NPH, k = ph % NPH;
        const float* xin = args.in[half];
        float* DH = args.out + (size_t)half * MH * DM;
        const int S = half ? 8192 : 2048, nseq = half ? 2 : 8, smask = S - 1;
        {
            int nsub = 0;
            if (k == 1 || k == 4 || k == 6 || k == 7 || k == 9 || k == 12 || k == 14 || k == 16 || k == 17) nsub = 1;
            if (k == 2) nsub = 3;
            if constexpr (CASE_ON(1)) {
#pragma unroll 1
            for (int sub = 0; sub < nsub; ++sub) pg8::gemm_phase(lds, ph, sub, ap0, (int)gridDim.x, (int)blockIdx.x, tid);
            }
        }
        int G = gridDim.x, bx = blockIdx.x; asm volatile("" : "+s"(G), "+s"(bx));
        const int lane = tid & 63, wave = __builtin_amdgcn_readfirstlane(tid >> 6);
        const int vcu = (G % 8 == 0) ? (bx % 8) * (G / 8) + bx / 8 : bx;
        const int gw = vcu * 8 + wave, NGW = G * 8;
        switch (k) {
        case 0: { if constexpr (CASE_ON(0)) {
            if (half == 0) {
                unsigned zz_ = 0u; asm volatile("" : "+v"(zz_)); const u32x4 zero4 = {zz_, zz_, zz_, zz_};
                LAS float* scr = (LAS float*)(lds + wave * 16384);
                const int nitems = args.njobs_items;
                for (int it = gw; it < nitems; it += NGW) {
                    int j = 0;
#pragma unroll
                    for (int jj = 1; jj < NJOBS; ++jj) if (it >= args.jobs[jj].item0) j = jj;
                    Job J; { const __attribute__((address_space(4))) Job* jp = &args.jobs[j]; J.src = jp->src; J.ksc = jp->ksc; J.dst = jp->dst; J.ld_src = jp->ld_src; J.Ksrc = jp->Ksrc; J.col0 = jp->col0; J.cpb = jp->cpb; J.cstride = jp->cstride; J.ld_dst = jp->ld_dst; J.row0 = jp->row0; J.kcol0 = jp->kcol0; J.nkt = jp->nkt; J.nnb = jp->nnb; J.item0 = jp->item0; }
                    p0_item(J, it - J.item0, scr, lane);
                }
                { u32x4* z = (u32x4*)(ws + OFF_WIN + (size_t)1056 * 1024 * 2); const int n = 224 * 1024 * 2 / 16; for (int i = gw * 64 + lane; i < n; i += NGW * 64) z[i] = zero4; }
                { u32x4* z = (u32x4*)(ws + OFF_WBIG + (size_t)3488 * 2048 * 2); const int n = 96 * 2048 * 2 / 16; for (int i = gw * 64 + lane; i < n; i += NGW * 64) z[i] = zero4; }
                for (int i = gw * 64 + lane; i < 8192 * 16; i += NGW * 64) {
                    const int pos = i >> 4, fi = i & 15;
                    const float pf = (float)pos, hi_ = ROPE_HI[fi], lo_ = ROPE_LO[fi];
                    const float pr = pf * hi_, er = __builtin_fmaf(pf, hi_, -pr);
                    float fr_ = pr - __builtin_floorf(pr); fr_ += (er + pf * lo_);
                    const float c = __builtin_amdgcn_cosf(fr_), s = __builtin_amdgcn_sinf(fr_);
                    rope[2 * i] = c; rope[2 * i + 1] = s;
                }
            }
            bf16* xb = (bf16*)(ws + A_XB);
            {
                const size_t n8 = (size_t)MH * DM / 8, stride = (size_t)NGW * 64;
                size_t i = (size_t)gw * 64 + lane;
                for (; i + 7 * stride < n8; i += 8 * stride) {
                    f32x4 a[8], b[8];
#pragma unroll
                    for (int u = 0; u < 8; ++u) { a[u] = *(const f32x4*)(xin + (i + u * stride) * 8); b[u] = *(const f32x4*)(xin + (i + u * stride) * 8 + 4); }
#pragma unroll
                    for (int u = 0; u < 8; ++u) pg8::st_bf16x8(xb + (i + u * stride) * 8, a[u], b[u]);
                }
                for (; i < n8; i += stride) { const f32x4 a = *(const f32x4*)(xin + i * 8), b = *(const f32x4*)(xin + i * 8 + 4); pg8::st_bf16x8(xb + i * 8, a, b); }
            }
        } } break;
        case 3: { if constexpr (CASE_ON(3)) {
            const int nqb = S / 256, nunits = nseq * NH * nqb, upc = (nunits + G - 1) / G;
            for (int i = 0; i < upc; ++i) {
                const int id = vcu * upc + i; if (id >= nunits) break;
                const int sh = id / nqb, qb = id % nqb, seq = sh / NH, h = sh % NH;
                attn::unit(lds, (const bf16*)(ws + A_Q), (const bf16*)(ws + A_KN), (const bf16*)(ws + A_KROPE), (const bf16*)(ws + A_VT), (bf16*)(ws + A_O), seq * S, S, h, qb, tid);
            }
        } } break;
        case 5: case 15: { if constexpr (CASE_ON(5)) {
            if (k == 5 || k == 15) break;
            const int layer = (k == 5) ? 0 : 1;
            const float* src = (k == 5) ? DH : (const float*)(ws + A_X2);
            const float* gg = args.in[28] + layer * DM; const float* bb = args.in[29] + layer * DM;
            bf16* xnb = (bf16*)(ws + A_XNB);
            for (int r = gw; r < MH; r += NGW) { f32x4 v[4]; ld_row(v, src + (size_t)r * DM, lane); ln_regs(v, gg, bb, lane); st_row(v, DH + (size_t)r * DM, lane); st_row_bf16(v, xnb + (size_t)r * DM, lane); }
        } } break;
        case 8: { if constexpr (CASE_ON(8)) {
            const float* gg = args.in[30]; const float* bb = args.in[31];
            float* x2 = (float*)(ws + A_X2); bf16* A2 = (bf16*)(ws + A_A2);
            for (int ch = gw; ch < MH / 8; ch += NGW) {
                const int t0 = ch * 8;
                f32x4 prev[4], cur[4], nxt[4];
                if ((t0 & smask) != 0) { ld_row(prev, DH + (size_t)(t0 - 1) * DM, lane); ln_regs(prev, gg, bb, lane); }
                else {
#pragma unroll
                    for (int j = 0; j < 4; ++j) prev[j] = (f32x4){0.f, 0.f, 0.f, 0.f}; }
                ld_row(cur, DH + (size_t)t0 * DM, lane); ln_regs(cur, gg, bb, lane);
#pragma unroll 1
                for (int i = 0; i < 8; ++i) {
                    const int t = t0 + i;
                    if ((t & smask) != smask) { ld_row(nxt, DH + (size_t)(t + 1) * DM, lane); ln_regs(nxt, gg, bb, lane); }
                    else {
#pragma unroll
                        for (int j = 0; j < 4; ++j) nxt[j] = (f32x4){0.f, 0.f, 0.f, 0.f}; }
                    st_row(cur, x2 + (size_t)t * DM, lane);
                    st_row_bf16(cur, A2 + (size_t)t * 2048, lane);
                    f32x4 xx[4];
#pragma unroll
                    for (int j = 0; j < 4; ++j) xx[j] = (prev[j] + nxt[j]) * 0.5f - cur[j];
                    st_row_bf16(xx, A2 + (size_t)t * 2048 + 1024, lane);
#pragma unroll
                    for (int j = 0; j < 4; ++j) { prev[j] = cur[j]; cur[j] = nxt[j]; }
                }
            }
        } } break;
        case 10: { if constexpr (CASE_ON(10)) {
        } } break;
        case 11: { if constexpr (CASE_ON(11)) {
            const bf16* Rb = (const bf16*)DH; const bf16* Kb = (const bf16*)DH + (size_t)MH * DM; const bf16* Vb = (const bf16*)(ws + A_V); const bf16* Lb = (const bf16*)(ws + A_L);
            bf16* Y = (bf16*)(ws + A_Y); float* coef = (float*)(ws + A_COEF);
#if defined(PROBE_MASK)
            const int pmode = (rep_cnt == half) ? PROBE_MASK : 0;
#else
            const int pmode = 0;
#endif
            if (half == 0) {
                for (int p = bx; p < 2 * 8 * NH; p += G) {
                    scan::Prob P; P.e = p / (8 * NH); P.h = p % NH; P.tokbase = ((p / NH) % 8) * S; P.S = S; P.row0 = 0;
                    scan::run<4, 4, 4, 2, 1>(lds, P, Rb, Kb, Vb, Lb, w2t, a2t, args.in[13], args.in[16], args.in[21], args.in[22], args.in[23], Y, coef, tid, pmode);
                }
            } else {
                for (int p = bx; p < 2 * 2 * NH * 4; p += G) {
                    const int pr = p >> 2;
                    scan::Prob P; P.e = pr / (2 * NH); P.h = pr % NH; P.tokbase = ((pr / NH) % 2) * S; P.S = S; P.row0 = (p & 3) * 16;
                    scan::run<16, 4, 4, 2, 1>(lds, P, Rb, Kb, Vb, Lb, w2t, a2t, args.in[13], args.in[16], args.in[21], args.in[22], args.in[23], Y, coef, tid, pmode);
                }
            }
        } } break;
        case 13: { if constexpr (CASE_ON(13)) {
            const bf16* Y = (const bf16*)(ws + A_Y); const float* coef = (const float*)(ws + A_COEF); const bf16* Vb = (const bf16*)(ws + A_V); const bf16* Gb = (const bf16*)DH;
            bf16* Op = (bf16*)(ws + A_OPOST);
            const float* lg = args.in[24]; const float* lb = args.in[25];
            for (int r = gw; r < MH; r += NGW) {
#pragma unroll
                for (int j = 0; j < 4; ++j) {
                    const int c0 = 256 * j + 4 * lane, h = c0 >> 6;
                    const u32x2 y0 = *(const u32x2*)(Y + (size_t)r * DM + c0), y1 = *(const u32x2*)(Y + ((size_t)MH + r) * DM + c0);
                    f32x4 y = {__builtin_bit_cast(float, y0.x << 16) + __builtin_bit_cast(float, y1.x << 16), __builtin_bit_cast(float, y0.x & 0xffff0000u) + __builtin_bit_cast(float, y1.x & 0xffff0000u),
                               __builtin_bit_cast(float, y0.y << 16) + __builtin_bit_cast(float, y1.y << 16), __builtin_bit_cast(float, y0.y & 0xffff0000u) + __builtin_bit_cast(float, y1.y & 0xffff0000u)};
                    float s = (y[0] + y[1]) + (y[2] + y[3]); s = allred16(s);
                    const float mu = s * (1.0f / 64.0f);
                    y = y - mu;
                    float s2 = (y[0] * y[0] + y[1] * y[1]) + (y[2] * y[2] + y[3] * y[3]); s2 = allred16(s2);
                    const float rstd = __builtin_amdgcn_rsqf(s2 * (1.0f / 64.0f) + GN_EPS);
                    const float cf = coef[(size_t)r * NH + h] + coef[((size_t)MH + r) * NH + h];
                    const u32x2 vv = *(const u32x2*)(Vb + (size_t)r * DM + c0), gv = *(const u32x2*)(Gb + (size_t)r * DM + c0);
                    const f32x4 v = {__builtin_bit_cast(float, vv.x << 16), __builtin_bit_cast(float, vv.x & 0xffff0000u), __builtin_bit_cast(float, vv.y << 16), __builtin_bit_cast(float, vv.y & 0xffff0000u)};
                    const f32x4 gq = {__builtin_bit_cast(float, gv.x << 16), __builtin_bit_cast(float, gv.x & 0xffff0000u), __builtin_bit_cast(float, gv.y << 16), __builtin_bit_cast(float, gv.y & 0xffff0000u)};
                    const f32x4 gg = *(const f32x4*)(lg + c0), bb = *(const f32x4*)(lb + c0);
                    const f32x4 o = (y * rstd * gg + bb + v * cf) * gq;
                    pg8::st_bf16x4(Op + (size_t)r * DM + c0, o);
                }
            }
        } } break;
        case 18: { if constexpr (CASE_ON(18)) {
        } } break;
        default: break;
        }
#if defined(REP_LO)
        if (k == REP_HI && rep_cnt == half) { ph -= (REP_HI - REP_LO + 1); ++rep_cnt; }
#endif
        if (ph + 1 < ph_hi && args.coop && k != 10 && k != 5 && k != 15 && k != 18) {
            if (ph == ph_lo) cg::this_grid().sync();
            else xcd_barrier((unsigned*)args.ws, bar_st);
        }
#undef args
    }
}

extern "C" void kernel_launch(void* const* d_in, const int* in_sizes, int n_in, void* d_out, int out_size, void* d_ws, size_t ws_size, hipStream_t stream) {
    static int grid = 0;
    if (grid == 0) {
        if (n_in != 32 || ws_size < WS_NEED || out_size != 2 * MH * DM) { fprintf(stderr, "kernel_launch: unexpected problem (n_in %d, ws %zu, out %d)\n", n_in, ws_size, out_size); grid = -1; return; }
        int dev = 0, cus = 0;
        if (hipGetDevice(&dev) != hipSuccess || hipDeviceGetAttribute(&cus, hipDeviceAttributeMultiprocessorCount, dev) != hipSuccess) { grid = -1; return; }
        if (hipFuncSetAttribute((const void*)fwd, hipFuncAttributeMaxDynamicSharedMemorySize, LDS_BYTES) != hipSuccess) { fprintf(stderr, "kernel_launch: hipFuncSetAttribute failed\n"); grid = -1; return; }
        int per_cu = 0;
        if (hipOccupancyMaxActiveBlocksPerMultiprocessor(&per_cu, (const void*)fwd, 512, LDS_BYTES) != hipSuccess || per_cu < 1) fprintf(stderr, "kernel_launch: occupancy query reports %d\n", per_cu);
        (void)hipGetLastError();
        grid = cus;
    }
    if (grid < 0) return;
    Args a{};
    for (int i = 0; i < 32; ++i) a.in[i] = (const float*)d_in[i];
    a.out = (float*)d_out; a.ws = (unsigned char*)d_ws;
    unsigned char* ws = (unsigned char*)d_ws;
    int nj = 0, items = 0;
    auto add = [&](const float* src, const float* ksc, size_t dst_off, int ld_src, int Ksrc, int col0, int cpb, int cstride, int ld_dst, int row0, int kcol0, int nkt, int nnb) {
        Job& J = a.jobs[nj++]; J.src = src; J.ksc = ksc; J.dst = (bf16*)(ws + dst_off); J.ld_src = ld_src; J.Ksrc = Ksrc; J.col0 = col0; J.cpb = cpb; J.cstride = cstride;
        J.ld_dst = ld_dst; J.row0 = row0; J.kcol0 = kcol0; J.nkt = nkt; J.nnb = nnb; J.item0 = items; items += nkt * nnb; };
    const float* const* in = a.in;
    const float* mix = in[8];
    add(in[2], nullptr, OFF_WIN, 1056, 1024, 0, 33, 0, 1024, 0, 0, 16, 33);
    add(in[5], in[3], OFF_WQB, 1536, 768, 0, 48, 0, 768, 0, 0, 12, 48);
    add(in[6], in[4], OFF_WK, 2048, 256, 0, 2, 128, 256, 0, 0, 4, 32);
    add(in[6], in[4], OFF_WV, 2048, 256, 64, 2, 128, 256, 0, 0, 4, 32);
    add(in[7], nullptr, OFF_WO0, 1024, 1024, 0, 32, 0, 1024, 0, 0, 16, 32);
    for (int l = 0; l < 2; ++l) add(in[26] + (size_t)l * 1024 * 4096, nullptr, OFF_W1 + (size_t)l * 4096 * 1024 * 2, 4096, 1024, 0, 128, 0, 1024, 0, 0, 16, 128);
    for (int l = 0; l < 2; ++l) add(in[27] + (size_t)l * 4096 * 1024, nullptr, OFF_W2 + (size_t)l * 4096 * 1024 * 2, 1024, 4096, 0, 32, 0, 4096, 0, 0, 64, 32);
    { const int widx[3] = {9, 10, 11}, midx[3] = {0, 2, 3};
      for (int t = 0; t < 3; ++t) { add(in[widx[t]], nullptr, OFF_WBIG, 1024, 1024, 0, 32, 0, 2048, 1024 * t, 0, 16, 32);
                                    add(in[widx[t]], mix + midx[t] * 1024, OFF_WBIG, 1024, 1024, 0, 32, 0, 2048, 1024 * t, 1024, 16, 32); } }
    for (int e = 0; e < 2; ++e) { add(in[14] + (size_t)e * 1024 * 64, nullptr, OFF_WBIG, 64, 1024, 0, 2, 0, 2048, 3072 + 64 * e, 0, 16, 2);
                                  add(in[14] + (size_t)e * 1024 * 64, mix + 1 * 1024, OFF_WBIG, 64, 1024, 0, 2, 0, 2048, 3072 + 64 * e, 1024, 16, 2); }
    for (int e = 0; e < 2; ++e) { add(in[17] + (size_t)e * 1024 * 64, nullptr, OFF_WBIG, 64, 1024, 0, 2, 0, 2048, 3200 + 64 * e, 0, 16, 2);
                                  add(in[17] + (size_t)e * 1024 * 64, mix + 4 * 1024, OFF_WBIG, 64, 1024, 0, 2, 0, 2048, 3200 + 64 * e, 1024, 16, 2); }
    add(in[19], nullptr, OFF_WBIG, 160, 1024, 0, 5, 0, 2048, 3328, 0, 16, 5);
    add(in[19], mix + 5 * 1024, OFF_WBIG, 160, 1024, 0, 5, 0, 2048, 3328, 1024, 16, 5);
    add(in[20], nullptr, OFF_BG, 1024, 160, 0, 32, 0, 256, 0, 0, 4, 32);
    add(in[12], nullptr, OFF_WO1, 1024, 1024, 0, 32, 0, 1024, 0, 0, 16, 32);
    for (int e = 0; e < 2; ++e) add(in[15] + (size_t)e * 64 * 1024, nullptr, OFF_W2T + (size_t)e * 1024 * 64 * 2, 1024, 64, 0, 32, 0, 64, 0, 0, 1, 32);
    for (int e = 0; e < 2; ++e) add(in[18] + (size_t)e * 64 * 1024, nullptr, OFF_A2T + (size_t)e * 1024 * 64 * 2, 1024, 64, 0, 32, 0, 64, 0, 0, 1, 32);
    a.njobs_items = items;
#if ONE_LAUNCH
    a.ph_lo = 0; a.ph_hi = 2 * NPH; a.coop = 1;
    if (hipMemsetAsync(d_ws, 0, 196608, stream) != hipSuccess) { fprintf(stderr, "kernel_launch: hipMemsetAsync failed\n"); return; }
    void* kargs[] = {&a};
    hipError_t e = hipLaunchCooperativeKernel((const void*)fwd, dim3(grid), dim3(512), kargs, LDS_BYTES, stream);
    if (e != hipSuccess) fprintf(stderr, "cooperative launch failed: %s (grid %d)\n", hipGetErrorString(e), grid);
#else
    a.coop = 0;
    for (int ph = 0; ph < 2 * NPH; ++ph) { a.ph_lo = ph; a.ph_hi = ph + 1; fwd<<<dim3(grid), dim3(512), LDS_BYTES, stream>>>(a); }
#endif
}
```

```cpp
#include <hip/hip_runtime.h>
#include <hip/hip_cooperative_groups.h>
#include <cstdio>
#include <cstdint>
namespace cg = cooperative_groups;

#ifndef ONLY
#define ONLY -1
#endif
#ifndef ONLY_MASK
#define ONLY_MASK 0xFFFFFFFFu
#endif
#define CASE_ON(k) (((ONLY_MASK) >> (k)) & 1u)
#ifndef ONE_LAUNCH
#define ONE_LAUNCH 1
#endif

#define LAS __attribute__((address_space(3)))
typedef unsigned short bf16;
typedef short bf16x8 __attribute__((ext_vector_type(8)));
typedef short s16x4 __attribute__((ext_vector_type(4)));
typedef float f32x4 __attribute__((ext_vector_type(4)));
typedef float f32x2 __attribute__((ext_vector_type(2)));
typedef float f32x16 __attribute__((ext_vector_type(16)));
typedef unsigned u32x4 __attribute__((ext_vector_type(4)));
typedef unsigned u32x2 __attribute__((ext_vector_type(2)));
typedef __bf16 bf16x2_t __attribute__((ext_vector_type(2)));

constexpr int DM = 1024, MH = 16384, DFF = 4096, NH = 16;
constexpr float ALPHA = 1.41421356237309515f;
constexpr float LN_EPS = 1e-5f, RMS_EPS = 1e-6f, GN_EPS = 64e-5f;
constexpr float QSCALE = 0.10206207261596575f * 1.4426950408889634f;
constexpr int NPH = 19;

constexpr size_t MiB = 1u << 20;
constexpr size_t OFF_WIN = 1 * MiB;
constexpr size_t OFF_WQB = OFF_WIN + 1280 * 1024 * 2;
constexpr size_t OFF_WK = OFF_WQB + 1536 * 768 * 2;
constexpr size_t OFF_WV = OFF_WK + 1024 * 256 * 2;
constexpr size_t OFF_WO0 = OFF_WV + 1024 * 256 * 2;
constexpr size_t OFF_W1 = 9 * MiB;
constexpr size_t OFF_W2 = 25 * MiB;
constexpr size_t OFF_WBIG = 41 * MiB;
constexpr size_t OFF_BG = 55 * MiB;
constexpr size_t OFF_WO1 = OFF_BG + 1024 * 256 * 2;
constexpr size_t OFF_W2T = OFF_WO1 + 1024 * 1024 * 2;
constexpr size_t OFF_A2T = OFF_W2T + 2 * 1024 * 64 * 2;
constexpr size_t OFF_ROPE = 58 * MiB;
constexpr size_t ACT0 = 60 * MiB;
constexpr size_t A_XB = ACT0 + 0 * MiB, A_CQ = ACT0 + 32 * MiB, A_CKV = ACT0 + 56 * MiB, A_KROPE = ACT0 + 64 * MiB, A_SSQ = ACT0 + 65 * MiB;
constexpr size_t A_Q = ACT0 + 66 * MiB, A_KN = ACT0 + 114 * MiB, A_VT = ACT0 + 146 * MiB, A_O = ACT0 + 0 * MiB;
constexpr size_t A_XNB = ACT0 + 160 * MiB, A_HID = ACT0 + 0 * MiB;
constexpr size_t A_X2 = ACT0 + 0 * MiB, A_A2 = ACT0 + 64 * MiB, A_V = ACT0 + 128 * MiB, A_L = ACT0 + 160 * MiB, A_Y = ACT0 + 64 * MiB, A_COEF = ACT0 + 192 * MiB, A_OPOST = ACT0 + 160 * MiB;
constexpr size_t WS_NEED = 256 * MiB;
static_assert(OFF_WO0 + 1024 * 1024 * 2 <= OFF_W1 && OFF_A2T + 2 * 1024 * 64 * 2 <= OFF_ROPE, "ws map");

constexpr int LDS_BYTES = 147456;

__device__ __forceinline__ unsigned cvtpk(float lo, float hi) { f32x2 v = {lo, hi}; bf16x2_t b = __builtin_convertvector(v, bf16x2_t); return __builtin_bit_cast(unsigned, b); }
__device__ __forceinline__ bf16 f2bf(float f) { return (bf16)(cvtpk(f, 0.f) & 0xffffu); }
__device__ __forceinline__ float bf2f(bf16 b) { return __builtin_bit_cast(float, (unsigned)b << 16); }
__device__ __forceinline__ float sigmoidf_(float x) { return __builtin_amdgcn_rcpf(1.0f + __builtin_amdgcn_exp2f(-1.4426950408889634f * x)); }
__device__ __forceinline__ float wave_sum(float v) {
#pragma unroll
    for (int o = 1; o < 64; o <<= 1) v += __shfl_xor(v, o);
    return v;
}
template <int CTRL> __device__ __forceinline__ float dppf(float v) { return __builtin_bit_cast(float, __builtin_amdgcn_update_dpp(0, __builtin_bit_cast(int, v), CTRL, 0xf, 0xf, false)); }
__device__ __forceinline__ float allred4(float v) { v += dppf<0xB1>(v); v += dppf<0x4E>(v); return v; }
__device__ __forceinline__ float allred8(float v) { v += dppf<0xB1>(v); v += dppf<0x4E>(v); v += dppf<0x141>(v); return v; }
__device__ __forceinline__ float allred16(float v) { v = allred8(v); v += dppf<0x140>(v); return v; }

struct Job { const float* src; const float* ksc; bf16* dst; int ld_src, Ksrc, col0, cpb, cstride, ld_dst, row0, kcol0, nkt, nnb, item0, pad0, pad1, pad2; };
constexpr int NJOBS = 31;
struct Args {
    const float* in[32];
    float* out; unsigned char* ws;
    int ph_lo, ph_hi, coop, njobs_items;
    Job jobs[NJOBS];
};

namespace pg8 {
constexpr int BM = 256, BK = 64, HALF = 128, HTB = HALF * BK * 2, STAGE_BYTES = 8 * HTB, NXCD = 8, WGM = 8;
__device__ __forceinline__ int lds_byte(int r, int c) { const int st = (r >> 4) * 2 + (c >> 5), rr = r & 15, cc = c & 31, ob = rr * 64 + cc * 2; return st * 1024 + (ob ^ (((ob >> 9) & 1) << 5)); }
__device__ __forceinline__ void stage_rc(int b, int& R, int& C) { const int st = b / 1024, sb = b % 1024, swz = sb ^ (((sb >> 9) & 1) << 5); R = (st >> 1) * 16 + swz / 64; C = (st & 1) * 32 + (swz % 64) / 2; }
__device__ __forceinline__ int perm32(int rho) { const int n = rho >> 4, i = rho & 15; return 8 * (i >> 2) + 4 * n + (i & 3); }
struct Unit { int pm, pn; };
struct Gemm { const bf16* A; const bf16* Bt; int M, N, K, lda, ldb; };
struct StaticOrder {
    int nM, nN, nwg, G, c;
    __device__ void init(int M, int N, int G_, int c_) { nM = M / BM; nN = N / BM; nwg = nM * nN; G = G_; c = c_; }
    __device__ bool next(int i, Unit& u) const {
        const long L = (long)i * G + c; if (L >= nwg) return false;
        int wgid = (int)L; { const int q = nwg / NXCD, r = nwg % NXCD, xcd = wgid % NXCD, off = wgid / NXCD; wgid = (xcd < r ? xcd * (q + 1) : r * (q + 1) + (xcd - r) * q) + off; }
        const int nig = WGM * nN, gid = wgid / nig, fm = gid * WGM, gsz = (nM - fm) < WGM ? (nM - fm) : WGM;
        u.pm = fm + ((wgid % nig) % gsz); u.pn = (wgid % nig) / gsz; return true;
    }
};
struct GemmDesc { const bf16* A; const bf16* Bt; int M, N, K, lda, ldb, mode, perm, i0; void* p0; void* p1; void* p2; void* p3; void* p4; };
typedef const f32x4 (&AccRef)[2][2][4][2];
typedef const __attribute__((address_space(4))) Args* ArgP;
__device__ __forceinline__ void fill_desc(GemmDesc& d, int ph, int sub, ArgP ap) {
    unsigned char* ws = ap->ws;
    const int half = ph / NPH, k = ph % NPH;
    float* DH = ap->out + (size_t)half * MH * DM;
    const int smask = half ? 8191 : 2047;
    float* rope = (float*)(ws + OFF_ROPE);
    d.M = MH; d.N = DM; d.K = DM; d.lda = DM; d.ldb = DM; d.mode = 7; d.perm = 1; d.i0 = 0;
    d.A = nullptr; d.Bt = nullptr; d.p0 = nullptr; d.p1 = nullptr; d.p2 = nullptr; d.p3 = nullptr; d.p4 = nullptr;
    if (k == 1) { d.A = (const bf16*)(ws + A_XB); d.Bt = (const bf16*)(ws + OFF_WIN); d.N = 1280; d.mode = 0; d.perm = 0; d.i0 = smask;
        d.p0 = ws + A_CQ; d.p1 = ws + A_CKV; d.p2 = ws + A_KROPE; d.p3 = ws + A_SSQ; d.p4 = rope; }
    else if (k == 2 && sub == 0) { d.A = (const bf16*)(ws + A_CQ); d.Bt = (const bf16*)(ws + OFF_WQB); d.N = 1536; d.K = 768; d.lda = 768; d.ldb = 768; d.mode = 1; d.perm = 0; d.i0 = smask;
        d.p0 = ws + A_Q; d.p3 = ws + A_SSQ; d.p4 = rope; }
    else if (k == 2 && sub == 1) { d.A = (const bf16*)(ws + A_CKV); d.Bt = (const bf16*)(ws + OFF_WK); d.K = 256; d.lda = 256; d.ldb = 256; d.mode = 2; d.p0 = ws + A_KN; d.p3 = ws + A_SSQ; }
    else if (k == 2) { d.A = (const bf16*)(ws + OFF_WV); d.Bt = (const bf16*)(ws + A_CKV); d.M = 1024; d.N = MH; d.K = 256; d.lda = 256; d.ldb = 256; d.mode = 3; d.p0 = ws + A_VT; d.p3 = ws + A_SSQ; }
    else if (k == 4) { d.A = (const bf16*)(ws + A_O); d.Bt = (const bf16*)(ws + OFF_WO0); d.mode = 8; d.perm = 0; d.p0 = DH; d.p1 = (void*)ap->in[half];
        d.p2 = (void*)ap->in[28]; d.p3 = (void*)ap->in[29]; d.p4 = ws + A_XNB; d.i0 = half * 3; }
    else if (k == 6 || k == 16) { d.A = (const bf16*)(ws + (k == 16 ? A_V : A_XNB)); d.Bt = (const bf16*)(ws + OFF_W1) + (size_t)(k == 16) * DFF * DM; d.N = DFF; d.mode = 5; d.p0 = ws + A_HID; }
    else if (k == 7 || k == 17) { d.A = (const bf16*)(ws + A_HID); d.Bt = (const bf16*)(ws + OFF_W2) + (size_t)(k == 17) * DFF * DM; d.K = DFF; d.lda = DFF; d.ldb = DFF; d.mode = 4; d.perm = 0; d.p0 = DH; d.p1 = DH;
        if (k == 17) { d.mode = 8; d.p2 = (void*)(ap->in[30] + DM); d.p3 = (void*)(ap->in[31] + DM); d.p4 = nullptr; d.i0 = half * 3 + 1; } }
    else if (k == 9) { d.A = (const bf16*)(ws + A_A2); d.Bt = (const bf16*)(ws + OFF_WBIG); d.N = 3584; d.K = 2048; d.lda = 2048; d.ldb = 2048; d.mode = 6;
        d.p0 = DH; d.p1 = (bf16*)DH + (size_t)MH * DM; d.p2 = ws + A_V; d.p3 = ws + A_L; }
    else if (k == 12) { d.A = (const bf16*)(ws + A_L) + 256; d.Bt = (const bf16*)(ws + OFF_BG); d.K = 256; d.lda = 512; d.ldb = 256; d.mode = 7; d.i0 = DM; d.p0 = DH; }
    else { d.A = (const bf16*)(ws + A_OPOST); d.Bt = (const bf16*)(ws + OFF_WO1); d.mode = 8; d.perm = 0; d.p0 = DH; d.p1 = ws + A_X2;
        d.p2 = (void*)(ap->in[28] + DM); d.p3 = (void*)(ap->in[29] + DM); d.p4 = ws + A_V; d.i0 = half * 3 + 2; }
}
__device__ __forceinline__ void epi_dispatch(const GemmDesc& d, AccRef acc, const Unit& u, int wr, int wc, int fr, int fq);
__device__ __forceinline__ void fused_ln(const GemmDesc& d, f32x4 (&acc)[2][2][4][2], const Unit& u, int wr, int wc, int fr, int fq, LAS unsigned char* lds, int wid, int lane, unsigned char* ws);
__device__ __forceinline__ void gemm_phase(LAS unsigned char* lds, int ph, int sub, ArgP ap0, int G_, int c_, const int tid_in) {
    int tid = tid_in; asm volatile("" : "+v"(tid));
    GemmDesc d0; fill_desc(d0, ph, sub, ap0);
    const Gemm g{d0.A, d0.Bt, d0.M, d0.N, d0.K, d0.lda, d0.ldb};
    StaticOrder S; S.init(d0.M, d0.N, G_, c_);
    const bool perm = d0.perm != 0;
    const int wid = __builtin_amdgcn_readfirstlane(tid >> 6), lane = tid & 63, wr = wid >> 2, wc = wid & 3, fr = lane & 15, fq = lane >> 4;
    const int K = g.K, nt = K / BK;
    unsigned voffA[2], voffB[2];
#pragma unroll
    for (int i = 0; i < 2; ++i) { int R, C; stage_rc(tid * 16 + i * 8192, R, C); const int Rb = perm ? ((R & ~31) + perm32(R & 31)) : R;
        voffA[i] = (unsigned)(R * g.lda + C) * 2u; voffB[i] = (unsigned)(Rb * g.ldb + C) * 2u; }
    const size_t kstep = (size_t)(BK * 2);
    const unsigned hstepA = (unsigned)HALF * g.lda * 2u, hstepB = (unsigned)HALF * g.ldb * 2u;
    const unsigned tstepA = 2u * hstepA, tstepB = 2u * hstepB;
    const unsigned ldsw = (unsigned)wid * 1024u;
    const int aoff = lds_byte(wr * 64 + fr, fq * 8), boff = lds_byte(wc * 32 + fr, fq * 8);
#define PG8_SA(b, h) (((b) * 2 + (h)) * HTB)
#define PG8_SB(b, h) ((4 + (b) * 2 + (h)) * HTB)
#define PG8_STAGE(bufoff, gbase, voff) do { _Pragma("unroll") for (int _i = 0; _i < 2; ++_i) \
        __builtin_amdgcn_global_load_lds((const unsigned*)((const char*)(gbase) + (voff)[_i]), (LAS unsigned*)(lds + (bufoff) + ldsw + _i * 8192), 16, 0, 0); } while (0)
#define PG8_LDA(dst, b, h) do { _Pragma("unroll") for (int m = 0; m < 4; ++m) _Pragma("unroll") for (int k = 0; k < 2; ++k) dst[m][k] = *(const LAS bf16x8*)(lds + PG8_SA(b, h) + aoff + m * 2048 + k * 1024); } while (0)
#define PG8_LDB(dst, b, h) do { _Pragma("unroll") for (int n = 0; n < 2; ++n) _Pragma("unroll") for (int k = 0; k < 2; ++k) dst[n][k] = *(const LAS bf16x8*)(lds + PG8_SB(b, h) + boff + n * 2048 + k * 1024); } while (0)
#define PG8_MMA(ai, bj, At, Bt) do { __builtin_amdgcn_s_setprio(1); _Pragma("unroll") for (int m = 0; m < 4; ++m) _Pragma("unroll") for (int n = 0; n < 2; ++n) _Pragma("unroll") for (int k = 0; k < 2; ++k) \
        acc[ai][bj][m][n] = __builtin_amdgcn_mfma_f32_16x16x32_bf16(Bt[n][k], At[m][k], acc[ai][bj][m][n], 0, 0, 0); __builtin_amdgcn_s_setprio(0); } while (0)
#define PG8_WAIT_V(n) asm volatile("s_waitcnt vmcnt(" #n ")" ::: "memory")
#define PG8_WAIT_L(n) asm volatile("s_waitcnt lgkmcnt(" #n ")" ::: "memory")
#define PG8_BAR __builtin_amdgcn_s_barrier()
#define PG8_SCHED __builtin_amdgcn_sched_barrier(0)
    Unit cur, nxt; int ui = 0;
    if (!S.next(0, cur)) return;
    f32x4 acc[2][2][4][2];
#pragma unroll
    for (int a = 0; a < 2; ++a)
#pragma unroll
        for (int b = 0; b < 2; ++b)
#pragma unroll
            for (int m = 0; m < 4; ++m)
#pragma unroll
                for (int n = 0; n < 2; ++n) acc[a][b][m][n] = (f32x4){0.f, 0.f, 0.f, 0.f};
    bf16x8 At[4][2], B0[2][2], B1[2][2];
    const char* cA = (const char*)g.A + (size_t)cur.pm * tstepA; const char* cB = (const char*)g.Bt + (size_t)cur.pn * tstepB;
    PG8_STAGE(PG8_SB(0, 0), cB, voffB); PG8_STAGE(PG8_SB(0, 1), cB + hstepB, voffB); PG8_STAGE(PG8_SA(0, 0), cA, voffA); PG8_STAGE(PG8_SA(0, 1), cA + hstepA, voffA);
    if (wr == 1) PG8_BAR;
    PG8_WAIT_V(2); PG8_BAR;
    PG8_STAGE(PG8_SB(1, 0), cB + kstep, voffB); PG8_STAGE(PG8_SA(1, 0), cA + kstep, voffA); PG8_STAGE(PG8_SB(1, 1), cB + hstepB + kstep, voffB);
    PG8_WAIT_V(6); PG8_BAR;
    for (;;) {
        const bool has_next = S.next(ui + 1, nxt);
        const char* nA = has_next ? (const char*)g.A + (size_t)nxt.pm * tstepA : cA; const char* nB = has_next ? (const char*)g.Bt + (size_t)nxt.pn * tstepB : cB;
        for (int t = 0; t < nt; t += 2) {
            const bool last = (t == nt - 2);
            const char* a1 = cA + (size_t)(t + 1) * kstep;
            const char* a2 = last ? nA : cA + (size_t)(t + 2) * kstep; const char* b2 = last ? nB : cB + (size_t)(t + 2) * kstep;
            const char* a3 = a2 + kstep; const char* b3 = b2 + kstep;
            PG8_LDB(B0, 0, 0); PG8_LDB(B1, 0, 1); PG8_SCHED; PG8_LDA(At, 0, 0); PG8_STAGE(PG8_SA(1, 1), a1 + hstepA, voffA);
            PG8_WAIT_V(8); PG8_WAIT_L(0); PG8_BAR; PG8_MMA(0, 0, At, B0); PG8_MMA(0, 1, At, B1); PG8_BAR; PG8_SCHED;
            PG8_LDA(At, 0, 1); PG8_STAGE(PG8_SB(0, 0), b2, voffB); PG8_STAGE(PG8_SB(0, 1), b2 + hstepB, voffB); PG8_STAGE(PG8_SA(0, 0), a2, voffA);
            PG8_WAIT_V(8); PG8_WAIT_L(0); PG8_BAR; PG8_MMA(1, 0, At, B0); PG8_MMA(1, 1, At, B1); PG8_BAR; PG8_SCHED;
            PG8_LDB(B0, 1, 0); PG8_LDB(B1, 1, 1); PG8_SCHED; PG8_LDA(At, 1, 0); PG8_STAGE(PG8_SA(0, 1), a2 + hstepA, voffA);
            PG8_WAIT_V(8); PG8_WAIT_L(0); PG8_BAR; PG8_MMA(0, 0, At, B0); PG8_MMA(0, 1, At, B1); PG8_BAR; PG8_SCHED;
            PG8_LDA(At, 1, 1); PG8_STAGE(PG8_SB(1, 0), b3, voffB); PG8_STAGE(PG8_SB(1, 1), b3 + hstepB, voffB); PG8_STAGE(PG8_SA(1, 0), a3, voffA);
            PG8_WAIT_V(8); PG8_WAIT_L(0); PG8_BAR; PG8_MMA(1, 0, At, B0); PG8_MMA(1, 1, At, B1); PG8_BAR; PG8_SCHED;
        }
        if (wr == 0) PG8_BAR;
        { int ph2 = ph, sub2 = sub; ArgP ap2 = ap0; asm volatile("" : "+s"(ph2), "+s"(sub2), "+s"(ap2));
          int t3 = tid; asm volatile("" : "+v"(t3)); const int wid3 = __builtin_amdgcn_readfirstlane(t3 >> 6), lane3 = t3 & 63;
          GemmDesc d; fill_desc(d, ph2, sub2, ap2); epi_dispatch(d, acc, cur, wid3 >> 2, wid3 & 3, lane3 & 15, lane3 >> 4); }
        if (!has_next) break;
#pragma unroll
        for (int a = 0; a < 2; ++a)
#pragma unroll
            for (int b = 0; b < 2; ++b)
#pragma unroll
                for (int m = 0; m < 4; ++m)
#pragma unroll
                    for (int n = 0; n < 2; ++n) acc[a][b][m][n] = (f32x4){0.f, 0.f, 0.f, 0.f};
        cur = nxt; cA = nA; cB = nB; ++ui;
        if (wr == 1) PG8_BAR;
    }
    PG8_WAIT_V(0);
    PG8_BAR;
    { int ph2 = ph, sub2 = sub; ArgP ap2 = ap0; asm volatile("" : "+s"(ph2), "+s"(sub2), "+s"(ap2));
      GemmDesc d; fill_desc(d, ph2, sub2, ap2);
      if (d.mode == 8) { int t2 = tid; asm volatile("" : "+v"(t2));
          const int wid2 = __builtin_amdgcn_readfirstlane(t2 >> 6), lane2 = t2 & 63;
          fused_ln(d, acc, cur, wid2 >> 2, wid2 & 3, lane2 & 15, lane2 >> 4, lds, wid2, lane2, ap2->ws); } }
#undef PG8_SA
#undef PG8_SB
#undef PG8_STAGE
#undef PG8_LDA
#undef PG8_LDB
#undef PG8_MMA
#undef PG8_WAIT_V
#undef PG8_WAIT_L
#undef PG8_BAR
#undef PG8_SCHED
}

__device__ __forceinline__ void st_bf16x4(bf16* p, f32x4 v) { u32x2 w; w.x = cvtpk(v[0], v[1]); w.y = cvtpk(v[2], v[3]); *(u32x2*)p = w; }
__device__ __forceinline__ void st_bf16x8(bf16* p, f32x4 v0, f32x4 v1) { u32x4 w; w.x = cvtpk(v0[0], v0[1]); w.y = cvtpk(v0[2], v0[3]); w.z = cvtpk(v1[0], v1[1]); w.w = cvtpk(v1[2], v1[3]); *(u32x4*)p = w; }

struct EpiP1 {
    static constexpr bool PERM = false;
    bf16* cq; bf16* ckv; bf16* krope; float* ssq; const float* rope; int smask;
    __device__ __forceinline__ void operator()(AccRef acc, const Unit& u, int wr, int wc, int fr, int fq) const {
        const int pn = u.pn;
        bf16* cq_ = cq; bf16* ckv_ = ckv;
        asm volatile("" : "+s"(cq_), "+s"(ckv_));
#pragma unroll
        for (int ai = 0; ai < 2; ++ai)
#pragma unroll
            for (int m = 0; m < 4; ++m) {
                asm volatile("" ::: "memory");
                const int row = u.pm * BM + ai * HALF + wr * 64 + m * 16 + fr;
                if (pn < 4) {
                    float s = 0.f;
#pragma unroll
                    for (int bj = 0; bj < 2; ++bj)
#pragma unroll
                        for (int n = 0; n < 2; ++n) { const f32x4 v = acc[ai][bj][m][n]; s += (v[0] * v[0] + v[1] * v[1]) + (v[2] * v[2] + v[3] * v[3]);
                            const int col = pn * BM + bj * HALF + wc * 32 + n * 16 + 4 * fq;
                            bf16* p = (pn < 3) ? cq_ + (size_t)row * 768 + col : ckv_ + (size_t)row * 256 + (col - 768);
                            st_bf16x4(p, v); }
                    s += __shfl_xor(s, 16); s += __shfl_xor(s, 32);
                    if (fq == 0) ssq[(size_t)row * 16 + pn * 4 + wc] = s;
                } else if (wc == 0) {
                    const f32x4 x1 = acc[ai][0][m][0], x2 = acc[ai][0][m][1];
                    const int pos = row & smask;
                    const f32x4 t0 = *(const f32x4*)(rope + ((size_t)pos * 16 + 4 * fq) * 2), t1 = *(const f32x4*)(rope + ((size_t)pos * 16 + 4 * fq) * 2 + 4);
                    const f32x4 c = {t0[0], t0[2], t1[0], t1[2]}, sn = {t0[1], t0[3], t1[1], t1[3]};
                    st_bf16x4(krope + (size_t)row * 32 + 4 * fq, x1 * c - x2 * sn);
                    st_bf16x4(krope + (size_t)row * 32 + 16 + 4 * fq, x2 * c + x1 * sn);
                }
            }
    }
};
struct EpiQ {
    static constexpr bool PERM = false;
    bf16* Q; const float* ssq; const float* rope; int smask;
    __device__ __forceinline__ void operator()(AccRef acc, const Unit& u, int wr, int wc, int fr, int fq) const {
#pragma unroll
        for (int ai = 0; ai < 2; ++ai)
#pragma unroll
            for (int m = 0; m < 4; ++m) {
                asm volatile("" ::: "memory");
                const int row = u.pm * BM + ai * HALF + wr * 64 + m * 16 + fr;
                const f32x4 s0 = *(const f32x4*)(ssq + (size_t)row * 16), s1 = *(const f32x4*)(ssq + (size_t)row * 16 + 4), s2 = *(const f32x4*)(ssq + (size_t)row * 16 + 8);
                const float ss = ((s0[0] + s0[1]) + (s0[2] + s0[3])) + ((s1[0] + s1[1]) + (s1[2] + s1[3])) + ((s2[0] + s2[1]) + (s2[2] + s2[3]));
                const float rs = __builtin_amdgcn_rsqf(ss * (1.0f / 768.0f) + RMS_EPS) * QSCALE;
                const int pos = row & smask;
#pragma unroll
                for (int bj = 0; bj < 2; ++bj) {
                    const int g = u.pn * 8 + bj * 4 + wc;
                    const int col = u.pn * BM + bj * HALF + wc * 32 + 4 * fq;
                    bf16* p = Q + (size_t)row * 1536 + col;
                    const f32x4 x1 = acc[ai][bj][m][0] * rs, x2 = acc[ai][bj][m][1] * rs;
                    if ((g % 3) == 2) {
                        const f32x4 t0 = *(const f32x4*)(rope + ((size_t)pos * 16 + 4 * fq) * 2), t1 = *(const f32x4*)(rope + ((size_t)pos * 16 + 4 * fq) * 2 + 4);
                        const f32x4 c = {t0[0], t0[2], t1[0], t1[2]}, sn = {t0[1], t0[3], t1[1], t1[3]};
                        st_bf16x4(p, x1 * c - x2 * sn); st_bf16x4(p + 16, x2 * c + x1 * sn);
                    } else { st_bf16x4(p, x1); st_bf16x4(p + 16, x2); }
                }
            }
    }
};
struct EpiKn {
    static constexpr bool PERM = true;
    bf16* Kn; const float* ssq;
    __device__ __forceinline__ void operator()(AccRef acc, const Unit& u, int wr, int wc, int fr, int fq) const {
        f32x4 s0[2][4];
#pragma unroll
        for (int ai = 0; ai < 2; ++ai)
#pragma unroll
            for (int m = 0; m < 4; ++m) s0[ai][m] = *(const f32x4*)(ssq + (size_t)(u.pm * BM + ai * HALF + wr * 64 + m * 16 + fr) * 16 + 12);
#pragma unroll
        for (int ai = 0; ai < 2; ++ai)
#pragma unroll
            for (int m = 0; m < 4; ++m) {
                const int row = u.pm * BM + ai * HALF + wr * 64 + m * 16 + fr;
                const float rs = __builtin_amdgcn_rsqf(((s0[ai][m][0] + s0[ai][m][1]) + (s0[ai][m][2] + s0[ai][m][3])) * (1.0f / 256.0f) + RMS_EPS);
#pragma unroll
                for (int bj = 0; bj < 2; ++bj) { const int col = u.pn * BM + bj * HALF + wc * 32 + 8 * fq;
                    st_bf16x8(Kn + (size_t)row * 1024 + col, acc[ai][bj][m][0] * rs, acc[ai][bj][m][1] * rs); }
            }
    }
};
struct EpiVt {
    static constexpr bool PERM = true;
    bf16* Vt; const float* ssq;
    __device__ __forceinline__ void operator()(AccRef acc, const Unit& u, int wr, int wc, int fr, int fq) const {
#pragma unroll
        for (int bj = 0; bj < 2; ++bj) {
            const int col = u.pn * BM + bj * HALF + wc * 32 + 8 * fq;
            float cs[8];
#pragma unroll
            for (int e = 0; e < 8; ++e) { const f32x4 s0 = *(const f32x4*)(ssq + (size_t)(col + e) * 16 + 12);
                cs[e] = __builtin_amdgcn_rsqf(((s0[0] + s0[1]) + (s0[2] + s0[3])) * (1.0f / 256.0f) + RMS_EPS); }
            asm volatile("" ::: "memory");
#pragma unroll
            for (int ai = 0; ai < 2; ++ai)
#pragma unroll
                for (int m = 0; m < 4; ++m) {
                    const int row = u.pm * BM + ai * HALF + wr * 64 + m * 16 + fr;
                    f32x4 v0 = acc[ai][bj][m][0], v1 = acc[ai][bj][m][1];
#pragma unroll
                    for (int e = 0; e < 4; ++e) { v0[e] *= cs[e]; v1[e] *= cs[4 + e]; }
                    st_bf16x8(Vt + (size_t)row * MH + col, v0, v1);
                }
            asm volatile("" ::: "memory");
        }
    }
};
struct EpiRes {
    static constexpr bool PERM = false;
    const float* res; float* out;
    __device__ __forceinline__ void operator()(AccRef acc, const Unit& u, int wr, int wc, int fr, int fq) const {
#pragma unroll
        for (int ai = 0; ai < 2; ++ai) {
            asm volatile("" ::: "memory");
            f32x4 rr[4][2][2];
#pragma unroll
            for (int m = 0; m < 4; ++m) {
                const size_t off = (size_t)(u.pm * BM + ai * HALF + wr * 64 + m * 16 + fr) * DM + u.pn * BM + wc * 32 + 4 * fq;
#pragma unroll
                for (int bj = 0; bj < 2; ++bj)
#pragma unroll
                    for (int n = 0; n < 2; ++n) rr[m][bj][n] = *(const f32x4*)(res + off + bj * HALF + n * 16);
            }
#pragma unroll
            for (int m = 0; m < 4; ++m) {
                const size_t off = (size_t)(u.pm * BM + ai * HALF + wr * 64 + m * 16 + fr) * DM + u.pn * BM + wc * 32 + 4 * fq;
#pragma unroll
                for (int bj = 0; bj < 2; ++bj)
#pragma unroll
                    for (int n = 0; n < 2; ++n) *(f32x4*)(out + off + bj * HALF + n * 16) = rr[m][bj][n] * ALPHA + acc[ai][bj][m][n];
            }
        }
    }
};
struct EpiUp {
    static constexpr bool PERM = true;
    bf16* H;
    __device__ __forceinline__ void operator()(AccRef acc, const Unit& u, int wr, int wc, int fr, int fq) const {
#pragma unroll
        for (int ai = 0; ai < 2; ++ai)
#pragma unroll
            for (int m = 0; m < 4; ++m) {
                asm volatile("" ::: "memory");
                const int row = u.pm * BM + ai * HALF + wr * 64 + m * 16 + fr;
#pragma unroll
                for (int bj = 0; bj < 2; ++bj) { const int col = u.pn * BM + bj * HALF + wc * 32 + 8 * fq;
                    f32x4 v0 = acc[ai][bj][m][0], v1 = acc[ai][bj][m][1];
#pragma unroll
                    for (int e = 0; e < 4; ++e) { const float a = fmaxf(v0[e], 0.f), b = fmaxf(v1[e], 0.f); v0[e] = a * a; v1[e] = b * b; }
                    st_bf16x8(H + (size_t)row * DFF + col, v0, v1); }
            }
    }
};
struct EpiBig {
    static constexpr bool PERM = true;
    bf16* R; bf16* Kk; bf16* V; bf16* L;
    __device__ __forceinline__ void operator()(AccRef acc, const Unit& u, int wr, int wc, int fr, int fq) const {
        const int pn = u.pn;
        bf16* r_ = R; bf16* k_ = Kk; bf16* v_ = V; bf16* l_ = L;
        asm volatile("" : "+s"(r_), "+s"(k_), "+s"(v_), "+s"(l_));
        bf16* base = r_; if (pn >= 4) base = k_; if (pn >= 8) base = v_;
#pragma unroll
        for (int ai = 0; ai < 2; ++ai)
#pragma unroll
            for (int m = 0; m < 4; ++m) {
                asm volatile("" ::: "memory");
                const int row = u.pm * BM + ai * HALF + wr * 64 + m * 16 + fr;
#pragma unroll
                for (int bj = 0; bj < 2; ++bj) {
                    const int cl = bj * HALF + wc * 32 + 8 * fq;
                    f32x4 v0 = acc[ai][bj][m][0], v1 = acc[ai][bj][m][1];
                    bf16* p;
                    if (pn < 12) { p = base + (size_t)row * DM + (pn & 3) * BM + cl; }
                    else if (pn == 12) { p = l_ + (size_t)row * 512 + cl;
                        if (bj == 0) {
#pragma unroll
                            for (int e = 0; e < 4; ++e) { v0[e] = 1.0f - 2.0f * __builtin_amdgcn_rcpf(__builtin_amdgcn_exp2f(2.8853900817779268f * v0[e]) + 1.0f); v1[e] = 1.0f - 2.0f * __builtin_amdgcn_rcpf(__builtin_amdgcn_exp2f(2.8853900817779268f * v1[e]) + 1.0f); } } }
                    else { p = l_ + (size_t)row * 512 + 256 + cl;
#pragma unroll
                        for (int e = 0; e < 4; ++e) { v0[e] = sigmoidf_(v0[e]); v1[e] = sigmoidf_(v1[e]); } }
                    st_bf16x8(p, v0, v1);
                }
            }
    }
};
struct EpiPlain {
    static constexpr bool PERM = true;
    bf16* O; int ldc;
    __device__ __forceinline__ void operator()(AccRef acc, const Unit& u, int wr, int wc, int fr, int fq) const {
#pragma unroll
        for (int ai = 0; ai < 2; ++ai)
#pragma unroll
            for (int m = 0; m < 4; ++m) {
                asm volatile("" ::: "memory");
                const int row = u.pm * BM + ai * HALF + wr * 64 + m * 16 + fr;
#pragma unroll
                for (int bj = 0; bj < 2; ++bj) { const int col = u.pn * BM + bj * HALF + wc * 32 + 8 * fq; st_bf16x8(O + (size_t)row * ldc + col, acc[ai][bj][m][0], acc[ai][bj][m][1]); }
            }
    }
};
__device__ __forceinline__ void epi_dispatch(const GemmDesc& d, AccRef acc, const Unit& u, int wr, int wc, int fr, int fq) {
    switch (d.mode) {
    case 0: { EpiP1 E{(bf16*)d.p0, (bf16*)d.p1, (bf16*)d.p2, (float*)d.p3, (const float*)d.p4, d.i0}; E(acc, u, wr, wc, fr, fq); } break;
    case 1: { EpiQ E{(bf16*)d.p0, (const float*)d.p3, (const float*)d.p4, d.i0}; E(acc, u, wr, wc, fr, fq); } break;
    case 2: { EpiKn E{(bf16*)d.p0, (const float*)d.p3}; E(acc, u, wr, wc, fr, fq); } break;
    case 3: { EpiVt E{(bf16*)d.p0, (const float*)d.p3}; E(acc, u, wr, wc, fr, fq); } break;
    case 4: { EpiRes E{(const float*)d.p1, (float*)d.p0}; E(acc, u, wr, wc, fr, fq); } break;
    case 5: { EpiUp E{(bf16*)d.p0}; E(acc, u, wr, wc, fr, fq); } break;
    case 6: { EpiBig E{(bf16*)d.p0, (bf16*)d.p1, (bf16*)d.p2, (bf16*)d.p3}; E(acc, u, wr, wc, fr, fq); } break;
    case 8: break;
    default: { EpiPlain E{(bf16*)d.p0, d.i0}; E(acc, u, wr, wc, fr, fq); } break;
    }
}
constexpr unsigned CW_SEAM = 16384, SEAM_BANK = 64 * 64;
constexpr size_t XBUF_OFF = 256 * 1024;
__device__ __forceinline__ void panel_stats(const f32x4 (&v)[2][2][4][2], const Unit& u, int wr, int wc, int fr, int fq, LAS unsigned char* lds, int wid, int lane, unsigned long long* xbuf, unsigned* cnt, float eps) {
    LAS f32x2* Pl = (LAS f32x2*)lds; LAS f32x2* Sl = (LAS f32x2*)(lds + 8192);
#pragma unroll
    for (int ai = 0; ai < 2; ++ai)
#pragma unroll
        for (int m = 0; m < 4; ++m) {
            float s = 0.f;
#pragma unroll
            for (int bj = 0; bj < 2; ++bj)
#pragma unroll
                for (int n = 0; n < 2; ++n) { const f32x4 x = v[ai][bj][m][n]; s += (x[0] + x[1]) + (x[2] + x[3]); }
            s += __shfl_xor(s, 16); s += __shfl_xor(s, 32);
            const float mw = s * (1.0f / 64.0f); float q = 0.f;
#pragma unroll
            for (int bj = 0; bj < 2; ++bj)
#pragma unroll
                for (int n = 0; n < 2; ++n) { const f32x4 dd = v[ai][bj][m][n] - mw; q += (dd[0] * dd[0] + dd[1] * dd[1]) + (dd[2] * dd[2] + dd[3] * dd[3]); }
            q += __shfl_xor(q, 16); q += __shfl_xor(q, 32);
            if (fq == 0) Pl[(ai * HALF + wr * 64 + m * 16 + fr) * 4 + wc] = (f32x2){mw, q};
            __builtin_amdgcn_sched_barrier(0);
        }
    asm volatile("s_waitcnt lgkmcnt(0)" ::: "memory"); __builtin_amdgcn_s_barrier(); asm volatile("" ::: "memory");
    const int row = wid * 32 + (lane & 31);
    if (lane < 32) {
        const f32x2 a = Pl[row * 4 + 0], b = Pl[row * 4 + 1], c = Pl[row * 4 + 2], dd = Pl[row * 4 + 3];
        const float mt = (a[0] + b[0] + c[0] + dd[0]) * 0.25f;
        const float da = a[0] - mt, db = b[0] - mt, dc = c[0] - mt, de = dd[0] - mt;
        const float m2 = (a[1] + b[1]) + (c[1] + dd[1]) + 64.0f * ((da * da + db * db) + (dc * dc + de * de));
        unsigned long long* slot = xbuf + ((size_t)(u.pm * BM + row) * 4 + u.pn);
        __hip_atomic_store(slot, ((unsigned long long)__builtin_bit_cast(unsigned, m2) << 32) | __builtin_bit_cast(unsigned, mt), __ATOMIC_RELAXED, __HIP_MEMORY_SCOPE_AGENT);
    }
    asm volatile("s_waitcnt vmcnt(0)" ::: "memory");
    if (lane == 0) __hip_atomic_fetch_add(cnt + 64 * u.pm, 1u, __ATOMIC_RELAXED, __HIP_MEMORY_SCOPE_AGENT);
    if (wid == 0) {
        for (unsigned sp = 0; sp < (1u << 22); ++sp) {
            if ((unsigned)__builtin_amdgcn_readfirstlane(__hip_atomic_load(cnt + 64 * u.pm, __ATOMIC_RELAXED, __HIP_MEMORY_SCOPE_AGENT)) >= 32u) break;
            __builtin_amdgcn_s_sleep(2);
        }
        __builtin_amdgcn_fence(__ATOMIC_ACQUIRE, "agent");
    }
    asm volatile("s_waitcnt vmcnt(0) lgkmcnt(0)" ::: "memory"); __builtin_amdgcn_s_barrier(); asm volatile("" ::: "memory");
    if (lane < 32) {
        const unsigned long long* slot = xbuf + (size_t)(u.pm * BM + row) * 4; float mt[4], m2[4]; float ms = 0.f;
#pragma unroll
        for (int t = 0; t < 4; ++t) { const unsigned long long w = __hip_atomic_load(slot + t, __ATOMIC_RELAXED, __HIP_MEMORY_SCOPE_AGENT); mt[t] = __builtin_bit_cast(float, (unsigned)w); m2[t] = __builtin_bit_cast(float, (unsigned)(w >> 32)); ms += mt[t]; }
        const float mean = ms * 0.25f; float q = 0.f;
#pragma unroll
        for (int t = 0; t < 4; ++t) { const float dm = mt[t] - mean; q += m2[t] + 256.0f * dm * dm; }
        Sl[row] = (f32x2){mean, 1.0f / sqrtf(q * (1.0f / 1024.0f) + eps)};
    }
    asm volatile("s_waitcnt lgkmcnt(0)" ::: "memory"); __builtin_amdgcn_s_barrier(); asm volatile("" ::: "memory");
}
__device__ __forceinline__ void fused_ln(const GemmDesc& d, f32x4 (&acc)[2][2][4][2], const Unit& u, int wr, int wc, int fr, int fq, LAS unsigned char* lds, int wid, int lane, unsigned char* ws) {
    const float* res = (const float*)d.p1; float* out = (float*)d.p0; const float* g = (const float*)d.p2; const float* b = (const float*)d.p3; bf16* xb = (bf16*)d.p4;
    const int col0 = u.pn * BM + wc * 32 + 4 * fq;
#pragma unroll
    for (int ai = 0; ai < 2; ++ai) {
        f32x4 rr[4][2][2];
#pragma unroll
        for (int m = 0; m < 4; ++m) {
            const size_t off = (size_t)(u.pm * BM + ai * HALF + wr * 64 + m * 16 + fr) * DM + col0;
#pragma unroll
            for (int bj = 0; bj < 2; ++bj)
#pragma unroll
                for (int n = 0; n < 2; ++n) rr[m][bj][n] = *(const f32x4*)(res + off + bj * HALF + n * 16);
        }
#pragma unroll
        for (int m = 0; m < 4; ++m) {
#pragma unroll
            for (int bj = 0; bj < 2; ++bj)
#pragma unroll
                for (int n = 0; n < 2; ++n) acc[ai][bj][m][n] = rr[m][bj][n] * ALPHA + acc[ai][bj][m][n];
            asm volatile("" : "+v"(acc[ai][0][m][0]), "+v"(acc[ai][0][m][1]), "+v"(acc[ai][1][m][0]), "+v"(acc[ai][1][m][1]));
        }
        asm volatile("" ::: "memory"); __builtin_amdgcn_sched_barrier(0);
    }
    panel_stats(acc, u, wr, wc, fr, fq, lds, wid, lane, (unsigned long long*)(ws + XBUF_OFF), (unsigned*)ws + CW_SEAM + (unsigned)d.i0 * SEAM_BANK, LN_EPS);
    const LAS f32x2* Sl = (const LAS f32x2*)(lds + 8192);
    int fr2 = fr, fq2 = fq; asm volatile("" : "+v"(fr2), "+v"(fq2));
    asm volatile("" : "+s"(g), "+s"(b), "+s"(out), "+s"(xb));
    const int col0b = u.pn * BM + wc * 32 + 4 * fq2;
    f32x4 ggv[2][2], bbv[2][2];
#pragma unroll
    for (int bj = 0; bj < 2; ++bj)
#pragma unroll
        for (int n = 0; n < 2; ++n) { ggv[bj][n] = *(const f32x4*)(g + col0b + bj * HALF + n * 16); bbv[bj][n] = *(const f32x4*)(b + col0b + bj * HALF + n * 16); }
#pragma unroll
    for (int ai = 0; ai < 2; ++ai)
#pragma unroll
        for (int m = 0; m < 4; ++m) {
            const int r = ai * HALF + wr * 64 + m * 16 + fr2; const f32x2 sr = Sl[r];
            const size_t off = (size_t)(u.pm * BM + r) * DM + col0b;
#pragma unroll
            for (int bj = 0; bj < 2; ++bj)
#pragma unroll
                for (int n = 0; n < 2; ++n) {
                    const f32x4 o = (acc[ai][bj][m][n] - sr[0]) * sr[1] * ggv[bj][n] + bbv[bj][n];
                    *(f32x4*)(out + off + bj * HALF + n * 16) = o;
                    if (xb) st_bf16x4(xb + off + bj * HALF + n * 16, o);
                }
            asm volatile("" ::: "memory"); __builtin_amdgcn_sched_barrier(0);
        }
}
}

__device__ __forceinline__ void p0_item(const Job& J, int item, LAS float* scr, int lane) {
    const int kb = item / J.nnb, nb = item % J.nnb, k0 = 64 * kb;
    const int scol = J.col0 + (nb / J.cpb) * J.cstride + (nb % J.cpb) * 32;
    float vals[32];
    const int kmax = J.Ksrc - 1, hk = lane >> 5, ln = lane & 31;
    const float* sp = J.src + scol + ln;
#pragma unroll
    for (int i = 0; i < 32; ++i) { const int k = k0 + 2 * i + hk; const int kc = k < kmax ? k : kmax; vals[i] = sp[(size_t)kc * J.ld_src]; }
    if (J.ksc) {
#pragma unroll
        for (int i = 0; i < 32; ++i) { const int k = k0 + 2 * i + hk; const int kc = k < kmax ? k : kmax; vals[i] *= J.ksc[kc]; }
    }
#pragma unroll
    for (int i = 0; i < 32; ++i) { const int kk = 2 * i + hk; scr[kk * 33 + ln] = (k0 + kk <= kmax) ? vals[i] : 0.f; }
    asm volatile("s_waitcnt lgkmcnt(0)" ::: "memory");
    const int c = lane & 7;
#pragma unroll
    for (int j = 0; j < 4; ++j) { const int n = (lane >> 3) + 8 * j; const LAS float* s = scr + (8 * c) * 33 + n;
        u32x4 o; o.x = cvtpk(s[0 * 33], s[1 * 33]); o.y = cvtpk(s[2 * 33], s[3 * 33]); o.z = cvtpk(s[4 * 33], s[5 * 33]); o.w = cvtpk(s[6 * 33], s[7 * 33]);
        *(u32x4*)(J.dst + (size_t)(J.row0 + nb * 32 + n) * J.ld_dst + J.kcol0 + k0 + 8 * c) = o; }
    asm volatile("s_waitcnt lgkmcnt(0)" ::: "memory");
}
__constant__ float ROPE_HI[16] = {1.591549367e-01f, 8.949939907e-02f, 5.032921210e-02f, 2.830219641e-02f, 1.591549441e-02f, 8.949940093e-03f, 5.032921210e-03f, 2.830219688e-03f, 1.591549488e-03f, 8.949940093e-04f, 5.032921326e-04f, 2.830219455e-04f, 1.591549371e-04f, 8.949940093e-05f, 5.032921035e-05f, 2.830219637e-05f};
__constant__ float ROPE_LO[16] = {6.420638243e-09f, 2.542919653e-09f, 5.173299289e-12f, -5.826552019e-10f, -1.029942243e-10f, 6.802745173e-11f, 5.173301024e-13f, -1.048316434e-10f, -5.686555046e-11f, 6.802744999e-12f, -1.158979943e-11f, 1.279990003e-11f, 5.954976963e-12f, 6.802745216e-13f, 1.751403167e-12f, -5.389994549e-13f};

namespace attn {
constexpr int KSTR = 208, VSTR = 136;
constexpr int KBYTES = 64 * KSTR, VBYTES = 64 * VSTR, BUFB = KBYTES + VBYTES;
constexpr int OST_OFF = 45056, OST_WAVE = 32 * 144;
__device__ __forceinline__ int crow(int r, int hi) { return (r & 3) + 8 * (r >> 2) + 4 * hi; }

__device__ __forceinline__ void unit(LAS unsigned char* lds, const bf16* __restrict__ Q, const bf16* __restrict__ Kn, const bf16* __restrict__ Kr, const bf16* __restrict__ Vt, bf16* __restrict__ O,
                                     int tokbase, int S, int h, int qb, const int tid) {
    const int lane = tid & 63, r32 = lane & 31, hi = lane >> 5, wid = __builtin_amdgcn_readfirstlane(tid >> 6);
    const int NT = S / 64;
    const int qrow = tokbase + qb * 256 + wid * 32 + r32;
    bf16x8 qf[6];
#pragma unroll
    for (int d0 = 0; d0 < 6; ++d0) qf[d0] = *(const bf16x8*)(Q + (size_t)qrow * 1536 + h * 96 + d0 * 16 + hi * 8);
    const int kkey = tid >> 3, kch = tid & 7;
    const int rkey = (tid & 255) >> 2, rch = tid & 3;
    const int vd = tid >> 3, vch = tid & 7;
    const bf16* kp = Kn + (size_t)(tokbase + kkey) * 1024 + h * 64 + kch * 8;
    const bf16* rp = Kr + (size_t)(tokbase + rkey) * 32 + rch * 8;
    const bf16* vp = Vt + (size_t)(h * 64 + vd) * MH + tokbase + vch * 8;
    u32x4 kreg, rreg = {0, 0, 0, 0}, vreg;
    kreg = *(const u32x4*)kp; if (tid < 256) rreg = *(const u32x4*)rp; vreg = *(const u32x4*)vp;
#define ATT_WRITE(buf) do { LAS unsigned char* b_ = lds + (buf) * BUFB; \
        *(LAS u32x4*)(b_ + kkey * KSTR + kch * 16) = kreg; \
        if (tid < 256) *(LAS u32x4*)(b_ + rkey * KSTR + 128 + rch * 16) = rreg; \
        *(LAS u32x2*)(b_ + KBYTES + vd * VSTR + vch * 16) = (u32x2){vreg.x, vreg.y}; \
        *(LAS u32x2*)(b_ + KBYTES + vd * VSTR + vch * 16 + 8) = (u32x2){vreg.z, vreg.w}; } while (0)
    ATT_WRITE(0);
    __syncthreads();
    float mref = 0.f, l_run = 0.f;
    f32x16 o0 = {}, o1 = {};
#define MAX3(a, b, c) ({ float r_; asm("v_max3_f32 %0, %1, %2, %3" : "=v"(r_) : "v"(a), "v"(b), "v"(c)); r_; })
    for (int t = 0; t < NT; ++t) {
        if (t + 1 < NT) {
            kreg = *(const u32x4*)(kp + (size_t)(t + 1) * 64 * 1024);
            if (tid < 256) rreg = *(const u32x4*)(rp + (size_t)(t + 1) * 64 * 32);
            vreg = *(const u32x4*)(vp + (size_t)(t + 1) * 64);
        }
        const LAS unsigned char* kb = lds + (t & 1) * BUFB;
        const LAS unsigned char* vb = kb + KBYTES;
        f32x16 p0 = {}, p1 = {};
        {
            bf16x8 kf0[6], kf1[6];
#pragma unroll
            for (int d0 = 0; d0 < 6; ++d0) { kf0[d0] = *(const LAS bf16x8*)(kb + r32 * KSTR + d0 * 32 + hi * 16); kf1[d0] = *(const LAS bf16x8*)(kb + (32 + r32) * KSTR + d0 * 32 + hi * 16); }
            __builtin_amdgcn_sched_barrier(0);
#pragma unroll
            for (int d0 = 0; d0 < 6; ++d0) { p0 = __builtin_amdgcn_mfma_f32_32x32x16_bf16(kf0[d0], qf[d0], p0, 0, 0, 0); p1 = __builtin_amdgcn_mfma_f32_32x32x16_bf16(kf1[d0], qf[d0], p1, 0, 0, 0); }
        }
        float mx = MAX3(p0[0], p0[1], p0[2]);
        mx = MAX3(mx, p0[3], p0[4]); mx = MAX3(mx, p0[5], p0[6]); mx = MAX3(mx, p0[7], p0[8]); mx = MAX3(mx, p0[9], p0[10]); mx = MAX3(mx, p0[11], p0[12]);
        mx = MAX3(mx, p0[13], p0[14]); mx = MAX3(mx, p0[15], p1[0]); mx = MAX3(mx, p1[1], p1[2]); mx = MAX3(mx, p1[3], p1[4]); mx = MAX3(mx, p1[5], p1[6]);
        mx = MAX3(mx, p1[7], p1[8]); mx = MAX3(mx, p1[9], p1[10]); mx = MAX3(mx, p1[11], p1[12]); mx = MAX3(mx, p1[13], p1[14]); mx = MAX3(mx, p1[15], p1[15]);
        { const float mo = __shfl_xor(mx, 32); mx = MAX3(mx, mo, mo); }
        if (__any(mx - mref > 8.0f)) {
            const float dl = fmaxf(mx - mref, 0.f);
            mref += dl;
            const float alpha = __builtin_amdgcn_exp2f(-dl);
            l_run *= alpha;
#pragma unroll
            for (int r = 0; r < 16; ++r) { o0[r] *= alpha; o1[r] *= alpha; }
        }
        if (__any(mref != 0.f)) {
            float la = 0.f, lb = 0.f, lc = 0.f, ld = 0.f;
#pragma unroll
            for (int r = 0; r < 16; r += 2) { p0[r] = __builtin_amdgcn_exp2f(p0[r] - mref); p1[r] = __builtin_amdgcn_exp2f(p1[r] - mref); p0[r + 1] = __builtin_amdgcn_exp2f(p0[r + 1] - mref); p1[r + 1] = __builtin_amdgcn_exp2f(p1[r + 1] - mref);
                la += p0[r]; lb += p1[r]; lc += p0[r + 1]; ld += p1[r + 1]; }
            l_run += (la + lb) + (lc + ld);
        } else {
            float la = 0.f, lb = 0.f, lc = 0.f, ld = 0.f;
#pragma unroll
            for (int r = 0; r < 16; r += 2) { p0[r] = __builtin_amdgcn_exp2f(p0[r]); p1[r] = __builtin_amdgcn_exp2f(p1[r]); p0[r + 1] = __builtin_amdgcn_exp2f(p0[r + 1]); p1[r + 1] = __builtin_amdgcn_exp2f(p1[r + 1]);
                la += p0[r]; lb += p1[r]; lc += p0[r + 1]; ld += p1[r + 1]; }
            l_run += (la + lb) + (lc + ld);
        }
        bf16x8 pb[2][2];
#pragma unroll
        for (int s = 0; s < 2; ++s) {
            u32x4 w0 = {cvtpk(p0[8 * s + 0], p0[8 * s + 1]), cvtpk(p0[8 * s + 2], p0[8 * s + 3]), cvtpk(p0[8 * s + 4], p0[8 * s + 5]), cvtpk(p0[8 * s + 6], p0[8 * s + 7])};
            u32x4 w1 = {cvtpk(p1[8 * s + 0], p1[8 * s + 1]), cvtpk(p1[8 * s + 2], p1[8 * s + 3]), cvtpk(p1[8 * s + 4], p1[8 * s + 5]), cvtpk(p1[8 * s + 6], p1[8 * s + 7])};
            pb[0][s] = __builtin_bit_cast(bf16x8, w0); pb[1][s] = __builtin_bit_cast(bf16x8, w1);
        }
        {
            bf16x8 vfa[2][2], vfb[2][2];
#pragma unroll
            for (int kt = 0; kt < 2; ++kt)
#pragma unroll
                for (int s = 0; s < 2; ++s) {
                    const int kcol = (kt * 32 + 16 * s + 4 * hi) * 2;
                    const u32x2 a0 = *(const LAS u32x2*)(vb + r32 * VSTR + kcol), a1 = *(const LAS u32x2*)(vb + r32 * VSTR + kcol + 16);
                    const u32x2 b0 = *(const LAS u32x2*)(vb + (32 + r32) * VSTR + kcol), b1 = *(const LAS u32x2*)(vb + (32 + r32) * VSTR + kcol + 16);
                    vfa[kt][s] = __builtin_bit_cast(bf16x8, (u32x4){a0.x, a0.y, a1.x, a1.y});
                    vfb[kt][s] = __builtin_bit_cast(bf16x8, (u32x4){b0.x, b0.y, b1.x, b1.y});
                }
            __builtin_amdgcn_sched_barrier(0);
#pragma unroll
            for (int kt = 0; kt < 2; ++kt)
#pragma unroll
                for (int s = 0; s < 2; ++s) {
                    o0 = __builtin_amdgcn_mfma_f32_32x32x16_bf16(vfa[kt][s], pb[kt][s], o0, 0, 0, 0);
                    o1 = __builtin_amdgcn_mfma_f32_32x32x16_bf16(vfb[kt][s], pb[kt][s], o1, 0, 0, 0);
                }
        }
        if (t + 1 < NT) ATT_WRITE((t + 1) & 1);
        __syncthreads();
    }
#undef ATT_WRITE
    l_run += __shfl_xor(l_run, 32);
    const float inv = 1.0f / l_run;
    LAS unsigned char* stg = lds + OST_OFF + wid * OST_WAVE;
#pragma unroll
    for (int r = 0; r < 16; ++r) { const int d = crow(r, hi);
        *(LAS bf16*)(stg + r32 * 144 + d * 2) = f2bf(o0[r] * inv);
        *(LAS bf16*)(stg + r32 * 144 + (32 + d) * 2) = f2bf(o1[r] * inv); }
    asm volatile("s_waitcnt lgkmcnt(0)" ::: "memory");
    bf16* Ow = O + (size_t)(tokbase + qb * 256 + wid * 32) * 1024 + h * 64;
#pragma unroll
    for (int i = 0; i < 4; ++i) { const int row = i * 8 + (lane >> 3), ch = lane & 7; const u32x4 v = *(const LAS u32x4*)(stg + row * 144 + ch * 16); *(u32x4*)(Ow + (size_t)row * 1024 + ch * 8) = v; }
    __syncthreads();
}
}

__device__ __forceinline__ void ln_regs(f32x4 (&v)[4], const float* g, const float* b, int lane) {
    float s = 0.f;
#pragma unroll
    for (int j = 0; j < 4; ++j) s += (v[j][0] + v[j][1]) + (v[j][2] + v[j][3]);
    const float mean = wave_sum(s) * (1.0f / DM); float s2 = 0.f;
#pragma unroll
    for (int j = 0; j < 4; ++j) { v[j] = v[j] - mean; s2 += (v[j][0] * v[j][0] + v[j][1] * v[j][1]) + (v[j][2] * v[j][2] + v[j][3] * v[j][3]); }
    const float rstd = __builtin_amdgcn_rsqf(wave_sum(s2) * (1.0f / DM) + LN_EPS);
#pragma unroll
    for (int j = 0; j < 4; ++j) { const f32x4 gg = *(const f32x4*)(g + 256 * j + 4 * lane), bb = *(const f32x4*)(b + 256 * j + 4 * lane); v[j] = v[j] * rstd * gg + bb; }
}
__device__ __forceinline__ void ld_row(f32x4 (&v)[4], const float* p, int lane) {
#pragma unroll
    for (int j = 0; j < 4; ++j) v[j] = *(const f32x4*)(p + 256 * j + 4 * lane);
}
__device__ __forceinline__ void st_row(const f32x4 (&v)[4], float* p, int lane) {
#pragma unroll
    for (int j = 0; j < 4; ++j) *(f32x4*)(p + 256 * j + 4 * lane) = v[j];
}
__device__ __forceinline__ void st_row_bf16(const f32x4 (&v)[4], bf16* p, int lane) {
#pragma unroll
    for (int j = 0; j < 4; ++j) pg8::st_bf16x4(p + 256 * j + 4 * lane, v[j]);
}

namespace scan {
constexpr int T = 32, SSTR = 400;
constexpr int BUF_FLOATS = T * SSTR;
constexpr int WB_OFF = 2 * BUF_FLOATS * 4;
constexpr int WB_STR = 144;

struct Prob { int e, h, tokbase, S, row0; };
struct PrepRegs { bf16x8 twA[2], alA[2]; u32x2 kx[4], rx[4], vx[4]; };

__device__ __forceinline__ int tok_of(const Prob& P, int tau) { return P.tokbase + (P.e ? (P.S - 1 - tau) : tau); }
__device__ __forceinline__ float xsum4(float v) { v += __shfl_xor(v, 16); v += __shfl_xor(v, 32); return v; }
__device__ __forceinline__ f32x4 bf4(u32x2 v) { return (f32x4){__builtin_bit_cast(float, v.x << 16), __builtin_bit_cast(float, v.x & 0xffff0000u), __builtin_bit_cast(float, v.y << 16), __builtin_bit_cast(float, v.y & 0xffff0000u)}; }

__device__ __forceinline__ void prep_load(PrepRegs& R, const Prob& P, int c, int st0, int lane,
                                          const bf16* __restrict__ Rb, const bf16* __restrict__ Kb, const bf16* __restrict__ Vb, const bf16* __restrict__ Lb) {
    const int c16 = lane & 15, q = lane >> 4;
    const int tok = tok_of(P, c * T + st0 + c16);
#pragma unroll
    for (int ks = 0; ks < 2; ++ks) {
        R.twA[ks] = *(const bf16x8*)(Lb + (size_t)tok * 512 + P.e * 64 + ks * 32 + 8 * q);
        R.alA[ks] = *(const bf16x8*)(Lb + (size_t)tok * 512 + 128 + P.e * 64 + ks * 32 + 8 * q);
    }
    const size_t o = (size_t)tok * DM + P.h * 64 + 4 * q;
#pragma unroll
    for (int nt = 0; nt < 4; ++nt) { R.kx[nt] = *(const u32x2*)(Kb + o + nt * 16); R.rx[nt] = *(const u32x2*)(Rb + o + nt * 16); R.vx[nt] = *(const u32x2*)(Vb + o + nt * 16); }
}
__device__ __forceinline__ void prep_compute(LAS float* buf, LAS unsigned char* wlds, const PrepRegs& R, const Prob& P, int c, int st0, int lane, float* coef) {
    const int c16 = lane & 15, q = lane >> 4;
    const LAS float* cst = (const LAS float*)(wlds + 2 * 64 * WB_STR) + 4 * q;
    const LAS unsigned char* wfr = wlds + c16 * WB_STR + q * 16;
    asm volatile("" : "+v"(cst), "+v"(wfr));
    f32x4 accw[4], acca[4];
#pragma unroll
    for (int nt = 0; nt < 4; ++nt) {
        accw[nt] = (f32x4){0.f, 0.f, 0.f, 0.f}; acca[nt] = (f32x4){0.f, 0.f, 0.f, 0.f};
#pragma unroll
        for (int ks = 0; ks < 2; ++ks) {
            const bf16x8 wB = *(const LAS bf16x8*)(wfr + nt * 16 * WB_STR + ks * 64);
            const bf16x8 aB = *(const LAS bf16x8*)(wfr + 64 * WB_STR + nt * 16 * WB_STR + ks * 64);
            accw[nt] = __builtin_amdgcn_mfma_f32_16x16x32_bf16(wB, R.twA[ks], accw[nt], 0, 0, 0);
            acca[nt] = __builtin_amdgcn_mfma_f32_16x16x32_bf16(aB, R.alA[ks], acca[nt], 0, 0, 0);
        }
    }
    const int st = st0 + c16;
    const int tok = tok_of(P, c * T + st);
    LAS float* rec = buf + st * SSTR + 4 * q;
    asm volatile("" : "+v"(rec));
    f32x4 kf[4], rf[4], av[4], kkr[4];
    float ss = 0.f;
#pragma unroll
    for (int nt = 0; nt < 4; ++nt) {
        const int ch0 = nt * 16;
        const f32x4 a0v = *(const LAS f32x4*)(cst + 64 + ch0), kkv = *(const LAS f32x4*)(cst + 128 + ch0);
        kf[nt] = bf4(R.kx[nt]); rf[nt] = bf4(R.rx[nt]);
#pragma unroll
        for (int e = 0; e < 4; ++e) { av[nt][e] = sigmoidf_(a0v[e] + acca[nt][e]); kkr[nt][e] = kf[nt][e] * kkv[e]; ss += kkr[nt][e] * kkr[nt][e]; }
    }
    ss = xsum4(ss);
    const float inv = __builtin_amdgcn_rsqf(fmaxf(ss, 1e-24f));
    float cf = 0.f, br = 0.f, kr = 0.f;
#pragma unroll
    for (int nt = 0; nt < 4; ++nt) {
        const int ch0 = nt * 16;
        const f32x4 w0v = *(const LAS f32x4*)(cst + ch0), kav = *(const LAS f32x4*)(cst + 192 + ch0), rkv = *(const LAS f32x4*)(cst + 256 + ch0);
        f32x4 nk, wv, bv, kdv, wrv;
#pragma unroll
        for (int e = 0; e < 4; ++e) {
            const float u = sigmoidf_(w0v[e] + accw[nt][e]);
            const float w = __builtin_amdgcn_exp2f(-0.8750387749145276f * u);
            const float kk = kkr[nt][e] * inv;
            const float kd = kf[nt][e] * (1.0f + (av[nt][e] - 1.0f) * kav[e]);
            const float b = kk * av[nt][e];
            cf += rf[nt][e] * kd * rkv[e]; br += b * rf[nt][e]; kr += kd * rf[nt][e];
            nk[e] = -kk; wv[e] = w; bv[e] = b; kdv[e] = kd; wrv[e] = w * rf[nt][e];
        }
        *(LAS f32x4*)(rec + ch0) = nk; *(LAS f32x4*)(rec + 64 + ch0) = wv; *(LAS f32x4*)(rec + 128 + ch0) = bv; *(LAS f32x4*)(rec + 192 + ch0) = kdv; *(LAS f32x4*)(rec + 256 + ch0) = wrv;
        *(LAS f32x4*)(rec + 320 + ch0) = bf4(R.vx[nt]);
    }
    cf = xsum4(cf); br = xsum4(br); kr = xsum4(kr);
    if (q == 0) { coef[((size_t)P.e * MH + tok) * NH + P.h] = cf; *(LAS f32x2*)(rec + 384) = (f32x2){br, kr};     }
}

template <int L, int NSW, int PW0, int NPAIR, int PD>
__device__ __forceinline__ void run(LAS unsigned char* lds, const Prob& P, const bf16* Rb, const bf16* Kb, const bf16* Vb, const bf16* Lb, const bf16* w2t, const bf16* a2t,
                                    const float* w0, const float* a0, const float* k_k, const float* k_a, const float* r_k, bf16* Yb, float* coef, const int tid_in, const int pm) {
    constexpr int EPL = 64 / L, RPW = 64 / L, NG = EPL / 4;
    int tid = tid_in; asm volatile("" : "+v"(tid));
    const int lane = tid & 63, wid = __builtin_amdgcn_readfirstlane(tid >> 6);
    LAS float* bufs = (LAS float*)lds;
    LAS unsigned char* wlds = lds + WB_OFF;
    const bool is_prep = (wid >= PW0 && wid < PW0 + 2 * NPAIR);
    const int pw = wid - PW0, st0 = (pw & 1) * 16;
    for (int i = tid; i < 2 * 64 * 8; i += 512) {
        const int m = i >> 9, chn = (i >> 3) & 63, kc = i & 7;
        const bf16* src = (m ? a2t : w2t) + ((size_t)P.e * 1024 + P.h * 64 + chn) * 64 + kc * 8;
        *(LAS u32x4*)(wlds + m * 64 * WB_STR + chn * WB_STR + kc * 16) = *(const u32x4*)src;
    }
    { LAS float* cstw = (LAS float*)(wlds + 2 * 64 * WB_STR); const int hch = P.h * 64 + lane;
      if (wid == 0) cstw[lane] = w0[P.e * 1024 + hch];
      if (wid == 1) cstw[64 + lane] = a0[P.e * 1024 + hch];
      if (wid == 2) cstw[128 + lane] = k_k[hch];
      if (wid == 3) cstw[192 + lane] = k_a[hch];
      if (wid == 4) cstw[256 + lane] = r_k[hch]; }
    const int NC = P.S / T;
    PrepRegs R;
    int lc = pw >> 1;
    if (is_prep) prep_load(R, P, lc, st0, lane, Rb, Kb, Vb, Lb);
    __syncthreads();
    if (is_prep && lc == 0) { prep_compute(bufs, wlds, R, P, 0, st0, lane, coef); lc += NPAIR; if (lc < NC) prep_load(R, P, lc, st0, lane, Rb, Kb, Vb, Lb); }
    __syncthreads();
    const int s = lane & (L - 1), rloc = lane / L;
    const int row = P.row0 + wid * RPW + rloc;
#define SCAN_BAR() asm volatile("s_waitcnt lgkmcnt(0)\n\ts_barrier" ::: "memory")
    if (is_prep) {
        for (int c = 0; c < NC; ++c) {
            if (lc == c + 1 && lc < NC) {
                if (!(pm & 1)) prep_compute(bufs + ((c + 1) & 1) * BUF_FLOATS, wlds, R, P, c + 1, st0, lane, coef);
                asm volatile("" ::: "memory"); __builtin_amdgcn_sched_barrier(0);
                lc += NPAIR; if (lc < NC) prep_load(R, P, lc, st0, lane, Rb, Kb, Vb, Lb);
                asm volatile("" ::: "memory"); __builtin_amdgcn_sched_barrier(0);
            }
            SCAN_BAR();
        }
    } else {
        float St[EPL];
#pragma unroll
        for (int e = 0; e < EPL; ++e) St[e] = 0.f;
        float ykeep = 0.f;
        for (int c = 0; c < NC; ++c) {
        if (wid < NSW && !(pm & 2)) {
            const LAS float* buf = bufs + (c & 1) * BUF_FLOATS;
            const LAS float* lb = buf + 4 * s; const LAS float* lv = buf + 320 + row;
            asm volatile("" : "+v"(lb), "+v"(lv));
            f32x4 naA[NG], wrA[NG], naB[NG], wrB[NG], w[NG], b[NG], kd[NG]; float vi; f32x2 sc;
#define SCAN_LOAD_NW(NA, WR, st_) do { const LAS float* rec_ = lb + (st_) * SSTR; \
                _Pragma("unroll") for (int g4 = 0; g4 < NG; ++g4) { const int j0 = g4 * (4 * L); NA[g4] = *(const LAS f32x4*)(rec_ + j0); WR[g4] = *(const LAS f32x4*)(rec_ + 256 + j0); } } while (0)
#define SCAN_LOAD_REST(st_) do { const LAS float* rec_ = lb + (st_) * SSTR; \
                _Pragma("unroll") for (int g4 = 0; g4 < NG; ++g4) { const int j0 = g4 * (4 * L); \
                    w[g4] = *(const LAS f32x4*)(rec_ + 64 + j0); b[g4] = *(const LAS f32x4*)(rec_ + 128 + j0); kd[g4] = *(const LAS f32x4*)(rec_ + 192 + j0); } \
                vi = lv[(st_) * SSTR]; sc = *(const LAS f32x2*)(buf + (st_) * SSTR + 384); } while (0)
#define SCAN_STEP(NA, WR, st_) do { \
                f32x2 a1_ = {0.f, 0.f}, a2_ = {0.f, 0.f}; \
                _Pragma("unroll") for (int g4 = 0; g4 < NG; ++g4) _Pragma("unroll") for (int e = 0; e < 4; e += 2) { \
                    const f32x2 s2_ = {St[g4 * 4 + e], St[g4 * 4 + e + 1]}; \
                    a1_ = s2_ * (f32x2){NA[g4][e], NA[g4][e + 1]} + a1_; a2_ = s2_ * (f32x2){WR[g4][e], WR[g4][e + 1]} + a2_; } \
                float d1 = a1_[0] + a1_[1], d2 = a2_[0] + a2_[1]; \
                if (L == 16) { d1 = allred16(d1); d2 = allred16(d2); } else if (L == 8) { d1 = allred8(d1); d2 = allred8(d2); } else { d1 = allred4(d1); d2 = allred4(d2); } \
                const float sa = d1, cv = vi; \
                const float y = d2 + sa * sc[0] + cv * sc[1]; \
                _Pragma("unroll") for (int g4 = 0; g4 < NG; ++g4) _Pragma("unroll") for (int e = 0; e < 4; ++e) St[g4 * 4 + e] = St[g4 * 4 + e] * w[g4][e] + (sa * b[g4][e] + cv * kd[g4][e]); \
                ykeep = (s == ((st_) & (L - 1))) ? y : ykeep; \
                if (((st_) & (L - 1)) == L - 1 && !(pm & 4)) { \
                    const int tok = tok_of(P, c * T + ((st_) - (L - 1)) + s); \
                    Yb[((size_t)P.e * MH + tok) * DM + P.h * 64 + row] = f2bf(ykeep); \
                } } while (0)
            SCAN_LOAD_NW(naA, wrA, 0);
#pragma unroll 1
            for (int st = 0; st < T; st += 2) {
                SCAN_LOAD_REST(st);
                SCAN_LOAD_NW(naB, wrB, st + 1);
                SCAN_STEP(naA, wrA, st);
                __builtin_amdgcn_sched_barrier(0);
                SCAN_LOAD_REST(st + 1);
                if (st + 2 < T) SCAN_LOAD_NW(naA, wrA, st + 2);
                SCAN_STEP(naB, wrB, st + 1);
                __builtin_amdgcn_sched_barrier(0);
            }
#undef SCAN_LOAD_NW
#undef SCAN_LOAD_REST
#undef SCAN_STEP
        }
            SCAN_BAR();
        }
    }
#undef SCAN_BAR
}
}

#define XB_TMO      128
#define XB_XCNT(j)  (256  + 64 * (j))
#define XB_XSUB(j)  (1280 + 64 * (j))
#define XB_XGEN(j)  (2304 + 64 * (j))
#define XB_TOP      3328
#define XB_TOPGEN   3392
#define XCD_BAR_WORDS 3456
#define XB_SPIN_CAP (1u << 22)
__device__ __forceinline__ unsigned xb_ld(unsigned* p)              { return __hip_atomic_load(p, __ATOMIC_RELAXED, __HIP_MEMORY_SCOPE_AGENT); }
__device__ __forceinline__ unsigned xb_add(unsigned* p, unsigned v) { return __hip_atomic_fetch_add(p, v, __ATOMIC_RELAXED, __HIP_MEMORY_SCOPE_AGENT); }
__device__ __forceinline__ unsigned xb_xcc_id() { return (unsigned)__builtin_amdgcn_s_getreg((3 << 11) | 20) & 0xFu; }
#define XB_SPIN(cond, bar) do { unsigned _sp = 0; while (cond) { __builtin_amdgcn_s_sleep(1); \
    if ((++_sp & 255u) == 0u) { if (xb_ld(&(bar)[XB_TMO])) break; if (_sp > XB_SPIN_CAP) { atomicAdd(&(bar)[XB_TMO], 1u); break; } } } } while (0)
__device__ __forceinline__ void xcd_barrier_complete(unsigned* bar, unsigned x, unsigned& nloc, unsigned& nx) {
    const unsigned G = gridDim.x * gridDim.y * gridDim.z;
    unsigned sum, cnt, mine, sp = 0u;
    for (;;) {
        sum = 0u; cnt = 0u; mine = 0u;
#pragma unroll
        for (unsigned j = 0; j < 16; ++j) { const unsigned c = xb_ld(&bar[XB_XCNT(j)]); sum += c; cnt += (c > 0u) ? 1u : 0u; mine = (j == x) ? c : mine; }
        if (sum == G) break;
        __builtin_amdgcn_s_sleep(1);
        if ((++sp & 255u) == 0u) { if (xb_ld(&bar[XB_TMO])) break; if (sp > XB_SPIN_CAP) { atomicAdd(&bar[XB_TMO], 1u); break; } }
    }
    nloc = mine > 0u ? mine : 1u; nx = cnt > 0u ? cnt : 1u;
}
__device__ __forceinline__ void xcd_barrier(unsigned* bar, volatile LAS unsigned* st) {
    asm volatile("s_waitcnt vmcnt(0)" ::: "memory");
    __syncthreads();
    if (threadIdx.x == 0) {
        const unsigned x = xb_xcc_id();
        __builtin_amdgcn_s_waitcnt(0);
        unsigned nloc = st[0], nx = st[1];
        if (nloc == 0u) { xcd_barrier_complete(bar, x, nloc, nx); st[0] = nloc; st[1] = nx; }
        const unsigned old = xb_add(&bar[XB_XSUB(x)], 1u);
        const unsigned gen = old / nloc;
        if (old + 1u == (gen + 1u) * nloc) {
            __builtin_amdgcn_fence(__ATOMIC_RELEASE, "agent");
            asm volatile("s_waitcnt vmcnt(0)" ::: "memory");
            const unsigned og = xb_add(&bar[XB_TOP], 1u);
            const unsigned tg = og / nx;
            if (og + 1u == (tg + 1u) * nx) xb_add(&bar[XB_TOPGEN], 1u);
            else XB_SPIN(xb_ld(&bar[XB_TOPGEN]) == tg, bar);
            __builtin_amdgcn_fence(__ATOMIC_ACQUIRE, "agent");
            xb_add(&bar[XB_XGEN(x)], 1u);
            asm volatile("s_waitcnt vmcnt(0)" ::: "memory");
        } else {
            XB_SPIN(xb_ld(&bar[XB_XGEN(x)]) == gen, bar);
            __builtin_amdgcn_fence(__ATOMIC_ACQUIRE, "agent");
            asm volatile("s_waitcnt vmcnt(0)" ::: "memory");
        }
    }
    __syncthreads();
}

__global__ void __launch_bounds__(512, 2) fwd(Args args_unused) {
    extern __shared__ __attribute__((aligned(16))) unsigned char lds_raw[];
    LAS unsigned char* lds = (LAS unsigned char*)lds_raw;
    typedef pg8::ArgP ArgP;
    const ArgP ap0 = (ArgP)__builtin_amdgcn_kernarg_segment_ptr();
    const int ph_lo = ap0->ph_lo, ph_hi = ap0->ph_hi;
    const int wid0 = __builtin_amdgcn_readfirstlane((int)threadIdx.x >> 6);
    volatile LAS unsigned* bar_st = (volatile LAS unsigned*)(lds + 131072 + 64);
    if (threadIdx.x == 0) { bar_st[0] = 0u; bar_st[1] = 0u; }
    __syncthreads();
    if (ap0->coop && threadIdx.x == 0) (void)xb_add((unsigned*)ap0->ws + XB_XCNT(xb_xcc_id()), 1u);

    int rep_cnt = 0; (void)rep_cnt;
    for (int ph = ph_lo; ph < ph_hi; ++ph) {
        ArgP ap = ap0; asm volatile("" : "+s"(ap));
        int tid; asm volatile("v_mbcnt_lo_u32_b32 %0, -1, 0\n\tv_mbcnt_hi_u32_b32 %0, -1, %0" : "=v"(tid)); tid += wid0 * 64;
        asm volatile("" : "+v"(tid));
#define args (*ap)
        unsigned char* ws = args.ws;
        const bf16* Win_t = (const bf16*)(ws + OFF_WIN); const bf16* Wqb_t = (const bf16*)(ws + OFF_WQB); const bf16* Wk_t = (const bf16*)(ws + OFF_WK); const bf16* Wv_t = (const bf16*)(ws + OFF_WV);
        const bf16* Wo0_t = (const bf16*)(ws + OFF_WO0); const bf16* Wbig_t = (const bf16*)(ws + OFF_WBIG); const bf16* Bg_t = (const bf16*)(ws + OFF_BG); const bf16* Wo1_t = (const bf16*)(ws + OFF_WO1);
        const bf16* w2t = (const bf16*)(ws + OFF_W2T); const bf16* a2t = (const bf16*)(ws + OFF_A2T);
        float* rope = (float*)(ws + OFF_ROPE);
        const int half = ph / NPH, k = ph % NPH;
        const float* xin = args.in[half];
        float* DH = args.out + (size_t)half * MH * DM;
        const int S = half ? 8192 : 2048, nseq = half ? 2 : 8, smask = S - 1;
        {
            int nsub = 0;
            if (k == 1 || k == 4 || k == 6 || k == 7 || k == 9 || k == 12 || k == 14 || k == 16 || k == 17) nsub = 1;
            if (k == 2) nsub = 3;
            if constexpr (CASE_ON(1)) {
#pragma unroll 1
            for (int sub = 0; sub < nsub; ++sub) pg8::gemm_phase(lds, ph, sub, ap0, (int)gridDim.x, (int)blockIdx.x, tid);
            }
        }
        int G = gridDim.x, bx = blockIdx.x; asm volatile("" : "+s"(G), "+s"(bx));
        const int lane = tid & 63, wave = __builtin_amdgcn_readfirstlane(tid >> 6);
        const int vcu = (G % 8 == 0) ? (bx % 8) * (G / 8) + bx / 8 : bx;
        const int gw = vcu * 8 + wave, NGW = G * 8;
        switch (k) {
        case 0: { if constexpr (CASE_ON(0)) {
            if (half == 0) {
                unsigned zz_ = 0u; asm volatile("" : "+v"(zz_)); const u32x4 zero4 = {zz_, zz_, zz_, zz_};
                LAS float* scr = (LAS float*)(lds + wave * 16384);
                const int nitems = args.njobs_items;
                for (int it = gw; it < nitems; it += NGW) {
                    int j = 0;
#pragma unroll
                    for (int jj = 1; jj < NJOBS; ++jj) if (it >= args.jobs[jj].item0) j = jj;
                    Job J; { const __attribute__((address_space(4))) Job* jp = &args.jobs[j]; J.src = jp->src; J.ksc = jp->ksc; J.dst = jp->dst; J.ld_src = jp->ld_src; J.Ksrc = jp->Ksrc; J.col0 = jp->col0; J.cpb = jp->cpb; J.cstride = jp->cstride; J.ld_dst = jp->ld_dst; J.row0 = jp->row0; J.kcol0 = jp->kcol0; J.nkt = jp->nkt; J.nnb = jp->nnb; J.item0 = jp->item0; }
                    p0_item(J, it - J.item0, scr, lane);
                }
                { u32x4* z = (u32x4*)(ws + OFF_WIN + (size_t)1056 * 1024 * 2); const int n = 224 * 1024 * 2 / 16; for (int i = gw * 64 + lane; i < n; i += NGW * 64) z[i] = zero4; }
                { u32x4* z = (u32x4*)(ws + OFF_WBIG + (size_t)3488 * 2048 * 2); const int n = 96 * 2048 * 2 / 16; for (int i = gw * 64 + lane; i < n; i += NGW * 64) z[i] = zero4; }
                for (int i = gw * 64 + lane; i < 8192 * 16; i += NGW * 64) {
                    const int pos = i >> 4, fi = i & 15;
                    const float pf = (float)pos, hi_ = ROPE_HI[fi], lo_ = ROPE_LO[fi];
                    const float pr = pf * hi_, er = __builtin_fmaf(pf, hi_, -pr);
                    float fr_ = pr - __builtin_floorf(pr); fr_ += (er + pf * lo_);
                    const float c = __builtin_amdgcn_cosf(fr_), s = __builtin_amdgcn_sinf(fr_);
                    rope[2 * i] = c; rope[2 * i + 1] = s;
                }
            }
            bf16* xb = (bf16*)(ws + A_XB);
            {
                const size_t n8 = (size_t)MH * DM / 8, stride = (size_t)NGW * 64;
                size_t i = (size_t)gw * 64 + lane;
                for (; i + 7 * stride < n8; i += 8 * stride) {
                    f32x4 a[8], b[8];
#pragma unroll
                    for (int u = 0; u < 8; ++u) { a[u] = *(const f32x4*)(xin + (i + u * stride) * 8); b[u] = *(const f32x4*)(xin + (i + u * stride) * 8 + 4); }
#pragma unroll
                    for (int u = 0; u < 8; ++u) pg8::st_bf16x8(xb + (i + u * stride) * 8, a[u], b[u]);
                }
                for (; i < n8; i += stride) { const f32x4 a = *(const f32x4*)(xin + i * 8), b = *(const f32x4*)(xin + i * 8 + 4); pg8::st_bf16x8(xb + i * 8, a, b); }
            }
        } } break;
        case 3: { if constexpr (CASE_ON(3)) {
            const int nqb = S / 256, nunits = nseq * NH * nqb, upc = (nunits + G - 1) / G;
            for (int i = 0; i < upc; ++i) {
                const int id = vcu * upc + i; if (id >= nunits) break;
                const int sh = id / nqb, qb = id % nqb, seq = sh / NH, h = sh % NH;
                attn::unit(lds, (const bf16*)(ws + A_Q), (const bf16*)(ws + A_KN), (const bf16*)(ws + A_KROPE), (const bf16*)(ws + A_VT), (bf16*)(ws + A_O), seq * S, S, h, qb, tid);
            }
        } } break;
        case 5: case 15: { if constexpr (CASE_ON(5)) {
            if (k == 5 || k == 15) break;
            const int layer = (k == 5) ? 0 : 1;
            const float* src = (k == 5) ? DH : (const float*)(ws + A_X2);
            const float* gg = args.in[28] + layer * DM; const float* bb = args.in[29] + layer * DM;
            bf16* xnb = (bf16*)(ws + A_XNB);
            for (int r = gw; r < MH; r += NGW) { f32x4 v[4]; ld_row(v, src + (size_t)r * DM, lane); ln_regs(v, gg, bb, lane); st_row(v, DH + (size_t)r * DM, lane); st_row_bf16(v, xnb + (size_t)r * DM, lane); }
        } } break;
        case 8: { if constexpr (CASE_ON(8)) {
            const float* gg = args.in[30]; const float* bb = args.in[31];
            float* x2 = (float*)(ws + A_X2); bf16* A2 = (bf16*)(ws + A_A2);
            for (int ch = gw; ch < MH / 8; ch += NGW) {
                const int t0 = ch * 8;
                f32x4 prev[4], cur[4], nxt[4];
                if ((t0 & smask) != 0) { ld_row(prev, DH + (size_t)(t0 - 1) * DM, lane); ln_regs(prev, gg, bb, lane); }
                else {
#pragma unroll
                    for (int j = 0; j < 4; ++j) prev[j] = (f32x4){0.f, 0.f, 0.f, 0.f}; }
                ld_row(cur, DH + (size_t)t0 * DM, lane); ln_regs(cur, gg, bb, lane);
#pragma unroll 1
                for (int i = 0; i < 8; ++i) {
                    const int t = t0 + i;
                    if ((t & smask) != smask) { ld_row(nxt, DH + (size_t)(t + 1) * DM, lane); ln_regs(nxt, gg, bb, lane); }
                    else {
#pragma unroll
                        for (int j = 0; j < 4; ++j) nxt[j] = (f32x4){0.f, 0.f, 0.f, 0.f}; }
                    st_row(cur, x2 + (size_t)t * DM, lane);
                    st_row_bf16(cur, A2 + (size_t)t * 2048, lane);
                    f32x4 xx[4];
#pragma unroll
                    for (int j = 0; j < 4; ++j) xx[j] = (prev[j] + nxt[j]) * 0.5f - cur[j];
                    st_row_bf16(xx, A2 + (size_t)t * 2048 + 1024, lane);
#pragma unroll
                    for (int j = 0; j < 4; ++j) { prev[j] = cur[j]; cur[j] = nxt[j]; }
                }
            }
        } } break;
        case 10: { if constexpr (CASE_ON(10)) {
        } } break;
        case 11: { if constexpr (CASE_ON(11)) {
            const bf16* Rb = (const bf16*)DH; const bf16* Kb = (const bf16*)DH + (size_t)MH * DM; const bf16* Vb = (const bf16*)(ws + A_V); const bf16* Lb = (const bf16*)(ws + A_L);
            bf16* Y = (bf16*)(ws + A_Y); float* coef = (float*)(ws + A_COEF);
#if defined(PROBE_MASK)
            const int pmode = (rep_cnt == half) ? PROBE_MASK : 0;
#else
            const int pmode = 0;
#endif
            if (half == 0) {
                for (int p = bx; p < 2 * 8 * NH; p += G) {
                    scan::Prob P; P.e = p / (8 * NH); P.h = p % NH; P.tokbase = ((p / NH) % 8) * S; P.S = S; P.row0 = 0;
                    scan::run<4, 4, 4, 2, 1>(lds, P, Rb, Kb, Vb, Lb, w2t, a2t, args.in[13], args.in[16], args.in[21], args.in[22], args.in[23], Y, coef, tid, pmode);
                }
            } else {
                for (int p = bx; p < 2 * 2 * NH * 4; p += G) {
                    const int pr = p >> 2;
                    scan::Prob P; P.e = pr / (2 * NH); P.h = pr % NH; P.tokbase = ((pr / NH) % 2) * S; P.S = S; P.row0 = (p & 3) * 16;
                    scan::run<16, 4, 4, 2, 1>(lds, P, Rb, Kb, Vb, Lb, w2t, a2t, args.in[13], args.in[16], args.in[21], args.in[22], args.in[23], Y, coef, tid, pmode);
                }
            }
        } } break;
        case 13: { if constexpr (CASE_ON(13)) {
            const bf16* Y = (const bf16*)(ws + A_Y); const float* coef = (const float*)(ws + A_COEF); const bf16* Vb = (const bf16*)(ws + A_V); const bf16* Gb = (const bf16*)DH;
            bf16* Op = (bf16*)(ws + A_OPOST);
            const float* lg = args.in[24]; const float* lb = args.in[25];
            for (int r = gw; r < MH; r += NGW) {
#pragma unroll
                for (int j = 0; j < 4; ++j) {
                    const int c0 = 256 * j + 4 * lane, h = c0 >> 6;
                    const u32x2 y0 = *(const u32x2*)(Y + (size_t)r * DM + c0), y1 = *(const u32x2*)(Y + ((size_t)MH + r) * DM + c0);
                    f32x4 y = {__builtin_bit_cast(float, y0.x << 16) + __builtin_bit_cast(float, y1.x << 16), __builtin_bit_cast(float, y0.x & 0xffff0000u) + __builtin_bit_cast(float, y1.x & 0xffff0000u),
                               __builtin_bit_cast(float, y0.y << 16) + __builtin_bit_cast(float, y1.y << 16), __builtin_bit_cast(float, y0.y & 0xffff0000u) + __builtin_bit_cast(float, y1.y & 0xffff0000u)};
                    float s = (y[0] + y[1]) + (y[2] + y[3]); s = allred16(s);
                    const float mu = s * (1.0f / 64.0f);
                    y = y - mu;
                    float s2 = (y[0] * y[0] + y[1] * y[1]) + (y[2] * y[2] + y[3] * y[3]); s2 = allred16(s2);
                    const float rstd = __builtin_amdgcn_rsqf(s2 * (1.0f / 64.0f) + GN_EPS);
                    const float cf = coef[(size_t)r * NH + h] + coef[((size_t)MH + r) * NH + h];
                    const u32x2 vv = *(const u32x2*)(Vb + (size_t)r * DM + c0), gv = *(const u32x2*)(Gb + (size_t)r * DM + c0);
                    const f32x4 v = {__builtin_bit_cast(float, vv.x << 16), __builtin_bit_cast(float, vv.x & 0xffff0000u), __builtin_bit_cast(float, vv.y << 16), __builtin_bit_cast(float, vv.y & 0xffff0000u)};
                    const f32x4 gq = {__builtin_bit_cast(float, gv.x << 16), __builtin_bit_cast(float, gv.x & 0xffff0000u), __builtin_bit_cast(float, gv.y << 16), __builtin_bit_cast(float, gv.y & 0xffff0000u)};
                    const f32x4 gg = *(const f32x4*)(lg + c0), bb = *(const f32x4*)(lb + c0);
                    const f32x4 o = (y * rstd * gg + bb + v * cf) * gq;
                    pg8::st_bf16x4(Op + (size_t)r * DM + c0, o);
                }
            }
        } } break;
        case 18: { if constexpr (CASE_ON(18)) {
        } } break;
        default: break;
        }
#if defined(REP_LO)
        if (k == REP_HI && rep_cnt == half) { ph -= (REP_HI - REP_LO + 1); ++rep_cnt; }
#endif
        if (ph + 1 < ph_hi && args.coop && k != 10 && k != 5 && k != 15 && k != 18) {
            if (ph == ph_lo) cg::this_grid().sync();
            else xcd_barrier((unsigned*)args.ws, bar_st);
        }
#undef args
    }
}

extern "C" void kernel_launch(void* const* d_in, const int* in_sizes, int n_in, void* d_out, int out_size, void* d_ws, size_t ws_size, hipStream_t stream) {
    static int grid = 0;
    if (grid == 0) {
        if (n_in != 32 || ws_size < WS_NEED || out_size != 2 * MH * DM) { fprintf(stderr, "kernel_launch: unexpected problem (n_in %d, ws %zu, out %d)\n", n_in, ws_size, out_size); grid = -1; return; }
        int dev = 0, cus = 0;
        if (hipGetDevice(&dev) != hipSuccess || hipDeviceGetAttribute(&cus, hipDeviceAttributeMultiprocessorCount, dev) != hipSuccess) { grid = -1; return; }
        if (hipFuncSetAttribute((const void*)fwd, hipFuncAttributeMaxDynamicSharedMemorySize, LDS_BYTES) != hipSuccess) { fprintf(stderr, "kernel_launch: hipFuncSetAttribute failed\n"); grid = -1; return; }
        int per_cu = 0;
        if (hipOccupancyMaxActiveBlocksPerMultiprocessor(&per_cu, (const void*)fwd, 512, LDS_BYTES) != hipSuccess || per_cu < 1) fprintf(stderr, "kernel_launch: occupancy query reports %d\n", per_cu);
        (void)hipGetLastError();
        grid = cus;
    }
    if (grid < 0) return;
    Args a{};
    for (int i = 0; i < 32; ++i) a.in[i] = (const float*)d_in[i];
    a.out = (float*)d_out; a.ws = (unsigned char*)d_ws;
    unsigned char* ws = (unsigned char*)d_ws;
    int nj = 0, items = 0;
    auto add = [&](const float* src, const float* ksc, size_t dst_off, int ld_src, int Ksrc, int col0, int cpb, int cstride, int ld_dst, int row0, int kcol0, int nkt, int nnb) {
        Job& J = a.jobs[nj++]; J.src = src; J.ksc = ksc; J.dst = (bf16*)(ws + dst_off); J.ld_src = ld_src; J.Ksrc = Ksrc; J.col0 = col0; J.cpb = cpb; J.cstride = cstride;
        J.ld_dst = ld_dst; J.row0 = row0; J.kcol0 = kcol0; J.nkt = nkt; J.nnb = nnb; J.item0 = items; items += nkt * nnb; };
    const float* const* in = a.in;
    const float* mix = in[8];
    add(in[2], nullptr, OFF_WIN, 1056, 1024, 0, 33, 0, 1024, 0, 0, 16, 33);
    add(in[5], in[3], OFF_WQB, 1536, 768, 0, 48, 0, 768, 0, 0, 12, 48);
    add(in[6], in[4], OFF_WK, 2048, 256, 0, 2, 128, 256, 0, 0, 4, 32);
    add(in[6], in[4], OFF_WV, 2048, 256, 64, 2, 128, 256, 0, 0, 4, 32);
    add(in[7], nullptr, OFF_WO0, 1024, 1024, 0, 32, 0, 1024, 0, 0, 16, 32);
    for (int l = 0; l < 2; ++l) add(in[26] + (size_t)l * 1024 * 4096, nullptr, OFF_W1 + (size_t)l * 4096 * 1024 * 2, 4096, 1024, 0, 128, 0, 1024, 0, 0, 16, 128);
    for (int l = 0; l < 2; ++l) add(in[27] + (size_t)l * 4096 * 1024, nullptr, OFF_W2 + (size_t)l * 4096 * 1024 * 2, 1024, 4096, 0, 32, 0, 4096, 0, 0, 64, 32);
    { const int widx[3] = {9, 10, 11}, midx[3] = {0, 2, 3};
      for (int t = 0; t < 3; ++t) { add(in[widx[t]], nullptr, OFF_WBIG, 1024, 1024, 0, 32, 0, 2048, 1024 * t, 0, 16, 32);
                                    add(in[widx[t]], mix + midx[t] * 1024, OFF_WBIG, 1024, 1024, 0, 32, 0, 2048, 1024 * t, 1024, 16, 32); } }
    for (int e = 0; e < 2; ++e) { add(in[14] + (size_t)e * 1024 * 64, nullptr, OFF_WBIG, 64, 1024, 0, 2, 0, 2048, 3072 + 64 * e, 0, 16, 2);
                                  add(in[14] + (size_t)e * 1024 * 64, mix + 1 * 1024, OFF_WBIG, 64, 1024, 0, 2, 0, 2048, 3072 + 64 * e, 1024, 16, 2); }
    for (int e = 0; e < 2; ++e) { add(in[17] + (size_t)e * 1024 * 64, nullptr, OFF_WBIG, 64, 1024, 0, 2, 0, 2048, 3200 + 64 * e, 0, 16, 2);
                                  add(in[17] + (size_t)e * 1024 * 64, mix + 4 * 1024, OFF_WBIG, 64, 1024, 0, 2, 0, 2048, 3200 + 64 * e, 1024, 16, 2); }
    add(in[19], nullptr, OFF_WBIG, 160, 1024, 0, 5, 0, 2048, 3328, 0, 16, 5);
    add(in[19], mix + 5 * 1024, OFF_WBIG, 160, 1024, 0, 5, 0, 2048, 3328, 1024, 16, 5);
    add(in[20], nullptr, OFF_BG, 1024, 160, 0, 32, 0, 256, 0, 0, 4, 32);
    add(in[12], nullptr, OFF_WO1, 1024, 1024, 0, 32, 0, 1024, 0, 0, 16, 32);
    for (int e = 0; e < 2; ++e) add(in[15] + (size_t)e * 64 * 1024, nullptr, OFF_W2T + (size_t)e * 1024 * 64 * 2, 1024, 64, 0, 32, 0, 64, 0, 0, 1, 32);
    for (int e = 0; e < 2; ++e) add(in[18] + (size_t)e * 64 * 1024, nullptr, OFF_A2T + (size_t)e * 1024 * 64 * 2, 1024, 64, 0, 32, 0, 64, 0, 0, 1, 32);
    a.njobs_items = items;
#if ONE_LAUNCH
    a.ph_lo = 0; a.ph_hi = 2 * NPH; a.coop = 1;
    if (hipMemsetAsync(d_ws, 0, 196608, stream) != hipSuccess) { fprintf(stderr, "kernel_launch: hipMemsetAsync failed\n"); return; }
    void* kargs[] = {&a};
    hipError_t e = hipLaunchCooperativeKernel((const void*)fwd, dim3(grid), dim3(512), kargs, LDS_BYTES, stream);
    if (e != hipSuccess) fprintf(stderr, "cooperative launch failed: %s (grid %d)\n", hipGetErrorString(e), grid);
#else
    a.coop = 0;
    for (int ph = 0; ph < 2 * NPH; ++ph) { a.ph_lo = ph; a.ph_hi = ph + 1; fwd<<<dim3(grid), dim3(512), LDS_BYTES, stream>>>(a); }
#endif
}
```

```cpp
#include <hip/hip_runtime.h>
#include <hip/hip_cooperative_groups.h>
#include <cstdio>
#include <cstdint>
namespace cg = cooperative_groups;

#ifndef ONLY
#define ONLY -1
#endif
#ifndef ONLY_MASK
#define ONLY_MASK 0xFFFFFFFFu
#endif
#define CASE_ON(k) (((ONLY_MASK) >> (k)) & 1u)
#ifndef ONE_LAUNCH
#define ONE_LAUNCH 1
#endif

#define LAS __attribute__((address_space(3)))
typedef unsigned short bf16;
typedef short bf16x8 __attribute__((ext_vector_type(8)));
typedef short s16x4 __attribute__((ext_vector_type(4)));
typedef float f32x4 __attribute__((ext_vector_type(4)));
typedef float f32x2 __attribute__((ext_vector_type(2)));
typedef float f32x16 __attribute__((ext_vector_type(16)));
typedef unsigned u32x4 __attribute__((ext_vector_type(4)));
typedef unsigned u32x2 __attribute__((ext_vector_type(2)));
typedef __bf16 bf16x2_t __attribute__((ext_vector_type(2)));

constexpr int DM = 1024, MH = 16384, DFF = 4096, NH = 16;
constexpr float ALPHA = 1.41421356237309515f;
constexpr float LN_EPS = 1e-5f, RMS_EPS = 1e-6f, GN_EPS = 64e-5f;
constexpr float QSCALE = 0.10206207261596575f * 1.4426950408889634f;
constexpr int NPH = 19;

constexpr size_t MiB = 1u << 20;
constexpr size_t OFF_WIN = 1 * MiB;
constexpr size_t OFF_WQB = OFF_WIN + 1280 * 1024 * 2;
constexpr size_t OFF_WK = OFF_WQB + 1536 * 768 * 2;
constexpr size_t OFF_WV = OFF_WK + 1024 * 256 * 2;
constexpr size_t OFF_WO0 = OFF_WV + 1024 * 256 * 2;
constexpr size_t OFF_W1 = 9 * MiB;
constexpr size_t OFF_W2 = 25 * MiB;
constexpr size_t OFF_WBIG = 41 * MiB;
constexpr size_t OFF_BG = 55 * MiB;
constexpr size_t OFF_WO1 = OFF_BG + 1024 * 256 * 2;
constexpr size_t OFF_W2T = OFF_WO1 + 1024 * 1024 * 2;
constexpr size_t OFF_A2T = OFF_W2T + 2 * 1024 * 64 * 2;
constexpr size_t OFF_ROPE = 58 * MiB;
constexpr size_t ACT0 = 60 * MiB;
constexpr size_t A_XB = ACT0 + 0 * MiB, A_CQ = ACT0 + 32 * MiB, A_CKV = ACT0 + 56 * MiB, A_KROPE = ACT0 + 64 * MiB, A_SSQ = ACT0 + 65 * MiB;
constexpr size_t A_Q = ACT0 + 66 * MiB, A_KN = ACT0 + 114 * MiB, A_VT = ACT0 + 146 * MiB, A_O = ACT0 + 0 * MiB;
constexpr size_t A_XNB = ACT0 + 160 * MiB, A_HID = ACT0 + 0 * MiB;
constexpr size_t A_X2 = ACT0 + 0 * MiB, A_A2 = ACT0 + 64 * MiB, A_V = ACT0 + 128 * MiB, A_L = ACT0 + 160 * MiB, A_Y = ACT0 + 64 * MiB, A_COEF = ACT0 + 192 * MiB, A_OPOST = ACT0 + 160 * MiB;
constexpr size_t WS_NEED = 256 * MiB;
static_assert(OFF_WO0 + 1024 * 1024 * 2 <= OFF_W1 && OFF_A2T + 2 * 1024 * 64 * 2 <= OFF_ROPE, "ws map");

constexpr int LDS_BYTES = 147456;

__device__ __forceinline__ unsigned cvtpk(float lo, float hi) { f32x2 v = {lo, hi}; bf16x2_t b = __builtin_convertvector(v, bf16x2_t); return __builtin_bit_cast(unsigned, b); }
__device__ __forceinline__ bf16 f2bf(float f) { return (bf16)(cvtpk(f, 0.f) & 0xffffu); }
__device__ __forceinline__ float bf2f(bf16 b) { return __builtin_bit_cast(float, (unsigned)b << 16); }
__device__ __forceinline__ float sigmoidf_(float x) { return __builtin_amdgcn_rcpf(1.0f + __builtin_amdgcn_exp2f(-1.4426950408889634f * x)); }
__device__ __forceinline__ float wave_sum(float v) {
#pragma unroll
    for (int o = 1; o < 64; o <<= 1) v += __shfl_xor(v, o);
    return v;
}
template <int CTRL> __device__ __forceinline__ float dppf(float v) { return __builtin_bit_cast(float, __builtin_amdgcn_update_dpp(0, __builtin_bit_cast(int, v), CTRL, 0xf, 0xf, false)); }
__device__ __forceinline__ float allred4(float v) { v += dppf<0xB1>(v); v += dppf<0x4E>(v); return v; }
__device__ __forceinline__ float allred8(float v) { v += dppf<0xB1>(v); v += dppf<0x4E>(v); v += dppf<0x141>(v); return v; }
__device__ __forceinline__ float allred16(float v) { v = allred8(v); v += dppf<0x140>(v); return v; }

struct Job { const float* src; const float* ksc; bf16* dst; int ld_src, Ksrc, col0, cpb, cstride, ld_dst, row0, kcol0, nkt, nnb, item0, pad0, pad1, pad2; };
constexpr int NJOBS = 31;
struct Args {
    const float* in[32];
    float* out; unsigned char* ws;
    int ph_lo, ph_hi, coop, njobs_items;
    Job jobs[NJOBS];
};

namespace pg8 {
constexpr int BM = 256, BK = 64, HALF = 128, HTB = HALF * BK * 2, STAGE_BYTES = 8 * HTB, NXCD = 8, WGM = 8;
__device__ __forceinline__ int lds_byte(int r, int c) { const int st = (r >> 4) * 2 + (c >> 5), rr = r & 15, cc = c & 31, ob = rr * 64 + cc * 2; return st * 1024 + (ob ^ (((ob >> 9) & 1) << 5)); }
__device__ __forceinline__ void stage_rc(int b, int& R, int& C) { const int st = b / 1024, sb = b % 1024, swz = sb ^ (((sb >> 9) & 1) << 5); R = (st >> 1) * 16 + swz / 64; C = (st & 1) * 32 + (swz % 64) / 2; }
__device__ __forceinline__ int perm32(int rho) { const int n = rho >> 4, i = rho & 15; return 8 * (i >> 2) + 4 * n + (i & 3); }
struct Unit { int pm, pn; };
struct Gemm { const bf16* A; const bf16* Bt; int M, N, K, lda, ldb; };
struct StaticOrder {
    int nM, nN, nwg, G, c;
    __device__ void init(int M, int N, int G_, int c_) { nM = M / BM; nN = N / BM; nwg = nM * nN; G = G_; c = c_; }
    __device__ bool next(int i, Unit& u) const {
        const long L = (long)i * G + c; if (L >= nwg) return false;
        int wgid = (int)L; { const int q = nwg / NXCD, r = nwg % NXCD, xcd = wgid % NXCD, off = wgid / NXCD; wgid = (xcd < r ? xcd * (q + 1) : r * (q + 1) + (xcd - r) * q) + off; }
        const int nig = WGM * nN, gid = wgid / nig, fm = gid * WGM, gsz = (nM - fm) < WGM ? (nM - fm) : WGM;
        u.pm = fm + ((wgid % nig) % gsz); u.pn = (wgid % nig) / gsz; return true;
    }
};
struct GemmDesc { const bf16* A; const bf16* Bt; int M, N, K, lda, ldb, mode, perm, i0; void* p0; void* p1; void* p2; void* p3; void* p4; };
typedef const f32x4 (&AccRef)[2][2][4][2];
typedef const __attribute__((address_space(4))) Args* ArgP;
__device__ __forceinline__ void fill_desc(GemmDesc& d, int ph, int sub, ArgP ap) {
    unsigned char* ws = ap->ws;
    const int half = ph / NPH, k = ph % NPH;
    float* DH = ap->out + (size_t)half * MH * DM;
    const int smask = half ? 8191 : 2047;
    float* rope = (float*)(ws + OFF_ROPE);
    d.M = MH; d.N = DM; d.K = DM; d.lda = DM; d.ldb = DM; d.mode = 7; d.perm = 1; d.i0 = 0;
    d.A = nullptr; d.Bt = nullptr; d.p0 = nullptr; d.p1 = nullptr; d.p2 = nullptr; d.p3 = nullptr; d.p4 = nullptr;
    if (k == 1) { d.A = (const bf16*)(ws + A_XB); d.Bt = (const bf16*)(ws + OFF_WIN); d.N = 1280; d.mode = 0; d.perm = 0; d.i0 = smask;
        d.p0 = ws + A_CQ; d.p1 = ws + A_CKV; d.p2 = ws + A_KROPE; d.p3 = ws + A_SSQ; d.p4 = rope; }
    else if (k == 2 && sub == 0) { d.A = (const bf16*)(ws + A_CQ); d.Bt = (const bf16*)(ws + OFF_WQB); d.N = 1536; d.K = 768; d.lda = 768; d.ldb = 768; d.mode = 1; d.perm = 0; d.i0 = smask;
        d.p0 = ws + A_Q; d.p3 = ws + A_SSQ; d.p4 = rope; }
    else if (k == 2 && sub == 1) { d.A = (const bf16*)(ws + A_CKV); d.Bt = (const bf16*)(ws + OFF_WK); d.K = 256; d.lda = 256; d.ldb = 256; d.mode = 2; d.p0 = ws + A_KN; d.p3 = ws + A_SSQ; }
    else if (k == 2) { d.A = (const bf16*)(ws + OFF_WV); d.Bt = (const bf16*)(ws + A_CKV); d.M = 1024; d.N = MH; d.K = 256; d.lda = 256; d.ldb = 256; d.mode = 3; d.p0 = ws + A_VT; d.p3 = ws + A_SSQ; }
    else if (k == 4) { d.A = (const bf16*)(ws + A_O); d.Bt = (const bf16*)(ws + OFF_WO0); d.mode = 8; d.perm = 0; d.p0 = DH; d.p1 = (void*)ap->in[half];
        d.p2 = (void*)ap->in[28]; d.p3 = (void*)ap->in[29]; d.p4 = ws + A_XNB; d.i0 = half * 3; }
    else if (k == 6 || k == 16) { d.A = (const bf16*)(ws + (k == 16 ? A_V : A_XNB)); d.Bt = (const bf16*)(ws + OFF_W1) + (size_t)(k == 16) * DFF * DM; d.N = DFF; d.mode = 5; d.p0 = ws + A_HID; }
    else if (k == 7 || k == 17) { d.A = (const bf16*)(ws + A_HID); d.Bt = (const bf16*)(ws + OFF_W2) + (size_t)(k == 17) * DFF * DM; d.K = DFF; d.lda = DFF; d.ldb = DFF; d.mode = 4; d.perm = 0; d.p0 = DH; d.p1 = DH;
        if (k == 17) { d.mode = 8; d.p2 = (void*)(ap->in[30] + DM); d.p3 = (void*)(ap->in[31] + DM); d.p4 = nullptr; d.i0 = half * 3 + 1; } }
    else if (k == 9) { d.A = (const bf16*)(ws + A_A2); d.Bt = (const bf16*)(ws + OFF_WBIG); d.N = 3584; d.K = 2048; d.lda = 2048; d.ldb = 2048; d.mode = 6;
        d.p0 = DH; d.p1 = (bf16*)DH + (size_t)MH * DM; d.p2 = ws + A_V; d.p3 = ws + A_L; }
    else if (k == 12) { d.A = (const bf16*)(ws + A_L) + 256; d.Bt = (const bf16*)(ws + OFF_BG); d.K = 256; d.lda = 512; d.ldb = 256; d.mode = 7; d.i0 = DM; d.p0 = DH; }
    else { d.A = (const bf16*)(ws + A_OPOST); d.Bt = (const bf16*)(ws + OFF_WO1); d.mode = 8; d.perm = 0; d.p0 = DH; d.p1 = ws + A_X2;
        d.p2 = (void*)(ap->in[28] + DM); d.p3 = (void*)(ap->in[29] + DM); d.p4 = ws + A_V; d.i0 = half * 3 + 2; }
}
__device__ __forceinline__ void epi_dispatch(const GemmDesc& d, AccRef acc, const Unit& u, int wr, int wc, int fr, int fq);
__device__ __forceinline__ void fused_ln(const GemmDesc& d, f32x4 (&acc)[2][2][4][2], const Unit& u, int wr, int wc, int fr, int fq, LAS unsigned char* lds, int wid, int lane, unsigned char* ws);
__device__ __forceinline__ void gemm_phase(LAS unsigned char* lds, int ph, int sub, ArgP ap0, int G_, int c_, const int tid_in) {
    int tid = tid_in; asm volatile("" : "+v"(tid));
    GemmDesc d0; fill_desc(d0, ph, sub, ap0);
    const Gemm g{d0.A, d0.Bt, d0.M, d0.N, d0.K, d0.lda, d0.ldb};
    StaticOrder S; S.init(d0.M, d0.N, G_, c_);
    const bool perm = d0.perm != 0;
    const int wid = __builtin_amdgcn_readfirstlane(tid >> 6), lane = tid & 63, wr = wid >> 2, wc = wid & 3, fr = lane & 15, fq = lane >> 4;
    const int K = g.K, nt = K / BK;
    unsigned voffA[2], voffB[2];
#pragma unroll
    for (int i = 0; i < 2; ++i) { int R, C; stage_rc(tid * 16 + i * 8192, R, C); const int Rb = perm ? ((R & ~31) + perm32(R & 31)) : R;
        voffA[i] = (unsigned)(R * g.lda + C) * 2u; voffB[i] = (unsigned)(Rb * g.ldb + C) * 2u; }
    const size_t kstep = (size_t)(BK * 2);
    const unsigned hstepA = (unsigned)HALF * g.lda * 2u, hstepB = (unsigned)HALF * g.ldb * 2u;
    const unsigned tstepA = 2u * hstepA, tstepB = 2u * hstepB;
    const unsigned ldsw = (unsigned)wid * 1024u;
    const int aoff = lds_byte(wr * 64 + fr, fq * 8), boff = lds_byte(wc * 32 + fr, fq * 8);
#define PG8_SA(b, h) (((b) * 2 + (h)) * HTB)
#define PG8_SB(b, h) ((4 + (b) * 2 + (h)) * HTB)
#define PG8_STAGE(bufoff, gbase, voff) do { _Pragma("unroll") for (int _i = 0; _i < 2; ++_i) \
        __builtin_amdgcn_global_load_lds((const unsigned*)((const char*)(gbase) + (voff)[_i]), (LAS unsigned*)(lds + (bufoff) + ldsw + _i * 8192), 16, 0, 0); } while (0)
#define PG8_LDA(dst, b, h) do { _Pragma("unroll") for (int m = 0; m < 4; ++m) _Pragma("unroll") for (int k = 0; k < 2; ++k) dst[m][k] = *(const LAS bf16x8*)(lds + PG8_SA(b, h) + aoff + m * 2048 + k * 1024); } while (0)
#define PG8_LDB(dst, b, h) do { _Pragma("unroll") for (int n = 0; n < 2; ++n) _Pragma("unroll") for (int k = 0; k < 2; ++k) dst[n][k] = *(const LAS bf16x8*)(lds + PG8_SB(b, h) + boff + n * 2048 + k * 1024); } while (0)
#define PG8_MMA(ai, bj, At, Bt) do { __builtin_amdgcn_s_setprio(1); _Pragma("unroll") for (int m = 0; m < 4; ++m) _Pragma("unroll") for (int n = 0; n < 2; ++n) _Pragma("unroll") for (int k = 0; k < 2; ++k) \
        acc[ai][bj][m][n] = __builtin_amdgcn_mfma_f32_16x16x32_bf16(Bt[n][k], At[m][k], acc[ai][bj][m][n], 0, 0, 0); __builtin_amdgcn_s_setprio(0); } while (0)
#define PG8_WAIT_V(n) asm volatile("s_waitcnt vmcnt(" #n ")" ::: "memory")
#define PG8_WAIT_L(n) asm volatile("s_waitcnt lgkmcnt(" #n ")" ::: "memory")
#define PG8_BAR __builtin_amdgcn_s_barrier()
#define PG8_SCHED __builtin_amdgcn_sched_barrier(0)
    Unit cur, nxt; int ui = 0;
    if (!S.next(0, cur)) return;
    f32x4 acc[2][2][4][2];
#pragma unroll
    for (int a = 0; a < 2; ++a)
#pragma unroll
        for (int b = 0; b < 2; ++b)
#pragma unroll
            for (int m = 0; m < 4; ++m)
#pragma unroll
                for (int n = 0; n < 2; ++n) acc[a][b][m][n] = (f32x4){0.f, 0.f, 0.f, 0.f};
    bf16x8 At[4][2], B0[2][2], B1[2][2];
    const char* cA = (const char*)g.A + (size_t)cur.pm * tstepA; const char* cB = (const char*)g.Bt + (size_t)cur.pn * tstepB;
    PG8_STAGE(PG8_SB(0, 0), cB, voffB); PG8_STAGE(PG8_SB(0, 1), cB + hstepB, voffB); PG8_STAGE(PG8_SA(0, 0), cA, voffA); PG8_STAGE(PG8_SA(0, 1), cA + hstepA, voffA);
    if (wr == 1) PG8_BAR;
    PG8_WAIT_V(2); PG8_BAR;
    PG8_STAGE(PG8_SB(1, 0), cB + kstep, voffB); PG8_STAGE(PG8_SA(1, 0), cA + kstep, voffA); PG8_STAGE(PG8_SB(1, 1), cB + hstepB + kstep, voffB);
    PG8_WAIT_V(6); PG8_BAR;
    for (;;) {
        const bool has_next = S.next(ui + 1, nxt);
        const char* nA = has_next ? (const char*)g.A + (size_t)nxt.pm * tstepA : cA; const char* nB = has_next ? (const char*)g.Bt + (size_t)nxt.pn * tstepB : cB;
        for (int t = 0; t < nt; t += 2) {
            const bool last = (t == nt - 2);
            const char* a1 = cA + (size_t)(t + 1) * kstep;
            const char* a2 = last ? nA : cA + (size_t)(t + 2) * kstep; const char* b2 = last ? nB : cB + (size_t)(t + 2) * kstep;
            const char* a3 = a2 + kstep; const char* b3 = b2 + kstep;
            PG8_LDB(B0, 0, 0); PG8_LDB(B1, 0, 1); PG8_SCHED; PG8_LDA(At, 0, 0); PG8_STAGE(PG8_SA(1, 1), a1 + hstepA, voffA);
            PG8_WAIT_V(8); PG8_WAIT_L(0); PG8_BAR; PG8_MMA(0, 0, At, B0); PG8_MMA(0, 1, At, B1); PG8_BAR; PG8_SCHED;
            PG8_LDA(At, 0, 1); PG8_STAGE(PG8_SB(0, 0), b2, voffB); PG8_STAGE(PG8_SB(0, 1), b2 + hstepB, voffB); PG8_STAGE(PG8_SA(0, 0), a2, voffA);
            PG8_WAIT_V(8); PG8_WAIT_L(0); PG8_BAR; PG8_MMA(1, 0, At, B0); PG8_MMA(1, 1, At, B1); PG8_BAR; PG8_SCHED;
            PG8_LDB(B0, 1, 0); PG8_LDB(B1, 1, 1); PG8_SCHED; PG8_LDA(At, 1, 0); PG8_STAGE(PG8_SA(0, 1), a2 + hstepA, voffA);
            PG8_WAIT_V(8); PG8_WAIT_L(0); PG8_BAR; PG8_MMA(0, 0, At, B0); PG8_MMA(0, 1, At, B1); PG8_BAR; PG8_SCHED;
            PG8_LDA(At, 1, 1); PG8_STAGE(PG8_SB(1, 0), b3, voffB); PG8_STAGE(PG8_SB(1, 1), b3 + hstepB, voffB); PG8_STAGE(PG8_SA(1, 0), a3, voffA);
            PG8_WAIT_V(8); PG8_WAIT_L(0); PG8_BAR; PG8_MMA(1, 0, At, B0); PG8_MMA(1, 1, At, B1); PG8_BAR; PG8_SCHED;
        }
        if (wr == 0) PG8_BAR;
        { int ph2 = ph, sub2 = sub; ArgP ap2 = ap0; asm volatile("" : "+s"(ph2), "+s"(sub2), "+s"(ap2));
          int t3 = tid; asm volatile("" : "+v"(t3)); const int wid3 = __builtin_amdgcn_readfirstlane(t3 >> 6), lane3 = t3 & 63;
          GemmDesc d; fill_desc(d, ph2, sub2, ap2); epi_dispatch(d, acc, cur, wid3 >> 2, wid3 & 3, lane3 & 15, lane3 >> 4); }
        if (!has_next) break;
#pragma unroll
        for (int a = 0; a < 2; ++a)
#pragma unroll
            for (int b = 0; b < 2; ++b)
#pragma unroll
                for (int m = 0; m < 4; ++m)
#pragma unroll
                    for (int n = 0; n < 2; ++n) acc[a][b][m][n] = (f32x4){0.f, 0.f, 0.f, 0.f};
        cur = nxt; cA = nA; cB = nB; ++ui;
        if (wr == 1) PG8_BAR;
    }
    PG8_WAIT_V(0);
    PG8_BAR;
    { int ph2 = ph, sub2 = sub; ArgP ap2 = ap0; asm volatile("" : "+s"(ph2), "+s"(sub2), "+s"(ap2));
      GemmDesc d; fill_desc(d, ph2, sub2, ap2);
      if (d.mode == 8) { int t2 = tid; asm volatile("" : "+v"(t2));
          const int wid2 = __builtin_amdgcn_readfirstlane(t2 >> 6), lane2 = t2 & 63;
          fused_ln(d, acc, cur, wid2 >> 2, wid2 & 3, lane2 & 15, lane2 >> 4, lds, wid2, lane2, ap2->ws); } }
#undef PG8_SA
#undef PG8_SB
#undef PG8_STAGE
#undef PG8_LDA
#undef PG8_LDB
#undef PG8_MMA
#undef PG8_WAIT_V
#undef PG8_WAIT_L
#undef PG8_BAR
#undef PG8_SCHED
}

__device__ __forceinline__ void st_bf16x4(bf16* p, f32x4 v) { u32x2 w; w.x = cvtpk(v[0], v[1]); w.y = cvtpk(v[2], v[3]); *(u32x2*)p = w; }
__device__ __forceinline__ void st_bf16x8(bf16* p, f32x4 v0, f32x4 v1) { u32x4 w; w.x = cvtpk(v0[0], v0[1]); w.y = cvtpk(v0[2], v0[3]); w.z = cvtpk(v1[0], v1[1]); w.w = cvtpk(v1[2], v1[3]); *(u32x4*)p = w; }

struct EpiP1 {
    static constexpr bool PERM = false;
    bf16* cq; bf16* ckv; bf16* krope; float* ssq; const float* rope; int smask;
    __device__ __forceinline__ void operator()(AccRef acc, const Unit& u, int wr, int wc, int fr, int fq) const {
        const int pn = u.pn;
        bf16* cq_ = cq; bf16* ckv_ = ckv;
        asm volatile("" : "+s"(cq_), "+s"(ckv_));
#pragma unroll
        for (int ai = 0; ai < 2; ++ai)
#pragma unroll
            for (int m = 0; m < 4; ++m) {
                asm volatile("" ::: "memory");
                const int row = u.pm * BM + ai * HALF + wr * 64 + m * 16 + fr;
                if (pn < 4) {
                    float s = 0.f;
#pragma unroll
                    for (int bj = 0; bj < 2; ++bj)
#pragma unroll
                        for (int n = 0; n < 2; ++n) { const f32x4 v = acc[ai][bj][m][n]; s += (v[0] * v[0] + v[1] * v[1]) + (v[2] * v[2] + v[3] * v[3]);
                            const int col = pn * BM + bj * HALF + wc * 32 + n * 16 + 4 * fq;
                            bf16* p = (pn < 3) ? cq_ + (size_t)row * 768 + col : ckv_ + (size_t)row * 256 + (col - 768);
                            st_bf16x4(p, v); }
                    s += __shfl_xor(s, 16); s += __shfl_xor(s, 32);
                    if (fq == 0) ssq[(size_t)row * 16 + pn * 4 + wc] = s;
                } else if (wc == 0) {
                    const f32x4 x1 = acc[ai][0][m][0], x2 = acc[ai][0][m][1];
                    const int pos = row & smask;
                    const f32x4 t0 = *(const f32x4*)(rope + ((size_t)pos * 16 + 4 * fq) * 2), t1 = *(const f32x4*)(rope + ((size_t)pos * 16 + 4 * fq) * 2 + 4);
                    const f32x4 c = {t0[0], t0[2], t1[0], t1[2]}, sn = {t0[1], t0[3], t1[1], t1[3]};
                    st_bf16x4(krope + (size_t)row * 32 + 4 * fq, x1 * c - x2 * sn);
                    st_bf16x4(krope + (size_t)row * 32 + 16 + 4 * fq, x2 * c + x1 * sn);
                }
            }
    }
};
struct EpiQ {
    static constexpr bool PERM = false;
    bf16* Q; const float* ssq; const float* rope; int smask;
    __device__ __forceinline__ void operator()(AccRef acc, const Unit& u, int wr, int wc, int fr, int fq) const {
#pragma unroll
        for (int ai = 0; ai < 2; ++ai)
#pragma unroll
            for (int m = 0; m < 4; ++m) {
                asm volatile("" ::: "memory");
                const int row = u.pm * BM + ai * HALF + wr * 64 + m * 16 + fr;
                const f32x4 s0 = *(const f32x4*)(ssq + (size_t)row * 16), s1 = *(const f32x4*)(ssq + (size_t)row * 16 + 4), s2 = *(const f32x4*)(ssq + (size_t)row * 16 + 8);
                const float ss = ((s0[0] + s0[1]) + (s0[2] + s0[3])) + ((s1[0] + s1[1]) + (s1[2] + s1[3])) + ((s2[0] + s2[1]) + (s2[2] + s2[3]));
                const float rs = __builtin_amdgcn_rsqf(ss * (1.0f / 768.0f) + RMS_EPS) * QSCALE;
                const int pos = row & smask;
#pragma unroll
                for (int bj = 0; bj < 2; ++bj) {
                    const int g = u.pn * 8 + bj * 4 + wc;
                    const int col = u.pn * BM + bj * HALF + wc * 32 + 4 * fq;
                    bf16* p = Q + (size_t)row * 1536 + col;
                    const f32x4 x1 = acc[ai][bj][m][0] * rs, x2 = acc[ai][bj][m][1] * rs;
                    if ((g % 3) == 2) {
                        const f32x4 t0 = *(const f32x4*)(rope + ((size_t)pos * 16 + 4 * fq) * 2), t1 = *(const f32x4*)(rope + ((size_t)pos * 16 + 4 * fq) * 2 + 4);
                        const f32x4 c = {t0[0], t0[2], t1[0], t1[2]}, sn = {t0[1], t0[3], t1[1], t1[3]};
                        st_bf16x4(p, x1 * c - x2 * sn); st_bf16x4(p + 16, x2 * c + x1 * sn);
                    } else { st_bf16x4(p, x1); st_bf16x4(p + 16, x2); }
                }
            }
    }
};
struct EpiKn {
    static constexpr bool PERM = true;
    bf16* Kn; const float* ssq;
    __device__ __forceinline__ void operator()(AccRef acc, const Unit& u, int wr, int wc, int fr, int fq) const {
        f32x4 s0[2][4];
#pragma unroll
        for (int ai = 0; ai < 2; ++ai)
#pragma unroll
            for (int m = 0; m < 4; ++m) s0[ai][m] = *(const f32x4*)(ssq + (size_t)(u.pm * BM + ai * HALF + wr * 64 + m * 16 + fr) * 16 + 12);
#pragma unroll
        for (int ai = 0; ai < 2; ++ai)
#pragma unroll
            for (int m = 0; m < 4; ++m) {
                const int row = u.pm * BM + ai * HALF + wr * 64 + m * 16 + fr;
                const float rs = __builtin_amdgcn_rsqf(((s0[ai][m][0] + s0[ai][m][1]) + (s0[ai][m][2] + s0[ai][m][3])) * (1.0f / 256.0f) + RMS_EPS);
#pragma unroll
                for (int bj = 0; bj < 2; ++bj) { const int col = u.pn * BM + bj * HALF + wc * 32 + 8 * fq;
                    st_bf16x8(Kn + (size_t)row * 1024 + col, acc[ai][bj][m][0] * rs, acc[ai][bj][m][1] * rs); }
            }
    }
};
struct EpiVt {
    static constexpr bool PERM = true;
    bf16* Vt; const float* ssq;
    __device__ __forceinline__ void operator()(AccRef acc, const Unit& u, int wr, int wc, int fr, int fq) const {
#pragma unroll
        for (int bj = 0; bj < 2; ++bj) {
            const int col = u.pn * BM + bj * HALF + wc * 32 + 8 * fq;
            float cs[8];
#pragma unroll
            for (int e = 0; e < 8; ++e) { const f32x4 s0 = *(const f32x4*)(ssq + (size_t)(col + e) * 16 + 12);
                cs[e] = __builtin_amdgcn_rsqf(((s0[0] + s0[1]) + (s0[2] + s0[3])) * (1.0f / 256.0f) + RMS_EPS); }
            asm volatile("" ::: "memory");
#pragma unroll
            for (int ai = 0; ai < 2; ++ai)
#pragma unroll
                for (int m = 0; m < 4; ++m) {
                    const int row = u.pm * BM + ai * HALF + wr * 64 + m * 16 + fr;
                    f32x4 v0 = acc[ai][bj][m][0], v1 = acc[ai][bj][m][1];
#pragma unroll
                    for (int e = 0; e < 4; ++e) { v0[e] *= cs[e]; v1[e] *= cs[4 + e]; }
                    st_bf16x8(Vt + (size_t)row * MH + col, v0, v1);
                }
            asm volatile("" ::: "memory");
        }
    }
};
struct EpiRes {
    static constexpr bool PERM = false;
    const float* res; float* out;
    __device__ __forceinline__ void operator()(AccRef acc, const Unit& u, int wr, int wc, int fr, int fq) const {
#pragma unroll
        for (int ai = 0; ai < 2; ++ai) {
            asm volatile("" ::: "memory");
            f32x4 rr[4][2][2];
#pragma unroll
            for (int m = 0; m < 4; ++m) {
                const size_t off = (size_t)(u.pm * BM + ai * HALF + wr * 64 + m * 16 + fr) * DM + u.pn * BM + wc * 32 + 4 * fq;
#pragma unroll
                for (int bj = 0; bj < 2; ++bj)
#pragma unroll
                    for (int n = 0; n < 2; ++n) rr[m][bj][n] = *(const f32x4*)(res + off + bj * HALF + n * 16);
            }
#pragma unroll
            for (int m = 0; m < 4; ++m) {
                const size_t off = (size_t)(u.pm * BM + ai * HALF + wr * 64 + m * 16 + fr) * DM + u.pn * BM + wc * 32 + 4 * fq;
#pragma unroll
                for (int bj = 0; bj < 2; ++bj)
#pragma unroll
                    for (int n = 0; n < 2; ++n) *(f32x4*)(out + off + bj * HALF + n * 16) = rr[m][bj][n] * ALPHA + acc[ai][bj][m][n];
            }
        }
    }
};
struct EpiUp {
    static constexpr bool PERM = true;
    bf16* H;
    __device__ __forceinline__ void operator()(AccRef acc, const Unit& u, int wr, int wc, int fr, int fq) const {
#pragma unroll
        for (int ai = 0; ai < 2; ++ai)
#pragma unroll
            for (int m = 0; m < 4; ++m) {
                asm volatile("" ::: "memory");
                const int row = u.pm * BM + ai * HALF + wr * 64 + m * 16 + fr;
#pragma unroll
                for (int bj = 0; bj < 2; ++bj) { const int col = u.pn * BM + bj * HALF + wc * 32 + 8 * fq;
                    f32x4 v0 = acc[ai][bj][m][0], v1 = acc[ai][bj][m][1];
#pragma unroll
                    for (int e = 0; e < 4; ++e) { const float a = fmaxf(v0[e], 0.f), b = fmaxf(v1[e], 0.f); v0[e] = a * a; v1[e] = b * b; }
                    st_bf16x8(H + (size_t)row * DFF + col, v0, v1); }
            }
    }
};
struct EpiBig {
    static constexpr bool PERM = true;
    bf16* R; bf16* Kk; bf16* V; bf16* L;
    __device__ __forceinline__ void operator()(AccRef acc, const Unit& u, int wr, int wc, int fr, int fq) const {
        const int pn = u.pn;
        bf16* r_ = R; bf16* k_ = Kk; bf16* v_ = V; bf16* l_ = L;
        asm volatile("" : "+s"(r_), "+s"(k_), "+s"(v_), "+s"(l_));
        bf16* base = r_; if (pn >= 4) base = k_; if (pn >= 8) base = v_;
#pragma unroll
        for (int ai = 0; ai < 2; ++ai)
#pragma unroll
            for (int m = 0; m < 4; ++m) {
                asm volatile("" ::: "memory");
                const int row = u.pm * BM + ai * HALF + wr * 64 + m * 16 + fr;
#pragma unroll
                for (int bj = 0; bj < 2; ++bj) {
                    const int cl = bj * HALF + wc * 32 + 8 * fq;
                    f32x4 v0 = acc[ai][bj][m][0], v1 = acc[ai][bj][m][1];
                    bf16* p;
                    if (pn < 12) { p = base + (size_t)row * DM + (pn & 3) * BM + cl; }
                    else if (pn == 12) { p = l_ + (size_t)row * 512 + cl;
                        if (bj == 0) {
#pragma unroll
                            for (int e = 0; e < 4; ++e) { v0[e] = 1.0f - 2.0f * __builtin_amdgcn_rcpf(__builtin_amdgcn_exp2f(2.8853900817779268f * v0[e]) + 1.0f); v1[e] = 1.0f - 2.0f * __builtin_amdgcn_rcpf(__builtin_amdgcn_exp2f(2.8853900817779268f * v1[e]) + 1.0f); } } }
                    else { p = l_ + (size_t)row * 512 + 256 + cl;
#pragma unroll
                        for (int e = 0; e < 4; ++e) { v0[e] = sigmoidf_(v0[e]); v1[e] = sigmoidf_(v1[e]); } }
                    st_bf16x8(p, v0, v1);
                }
            }
    }
};
struct EpiPlain {
    static constexpr bool PERM = true;
    bf16* O; int ldc;
    __device__ __forceinline__ void operator()(AccRef acc, const Unit& u, int wr, int wc, int fr, int fq) const {
#pragma unroll
        for (int ai = 0; ai < 2; ++ai)
#pragma unroll
            for (int m = 0; m < 4; ++m) {
                asm volatile("" ::: "memory");
                const int row = u.pm * BM + ai * HALF + wr * 64 + m * 16 + fr;
#pragma unroll
                for (int bj = 0; bj < 2; ++bj) { const int col = u.pn * BM + bj * HALF + wc * 32 + 8 * fq; st_bf16x8(O + (size_t)row * ldc + col, acc[ai][bj][m][0], acc[ai][bj][m][1]); }
            }
    }
};
__device__ __forceinline__ void epi_dispatch(const GemmDesc& d, AccRef acc, const Unit& u, int wr, int wc, int fr, int fq) {
    switch (d.mode) {
    case 0: { EpiP1 E{(bf16*)d.p0, (bf16*)d.p1, (bf16*)d.p2, (float*)d.p3, (const float*)d.p4, d.i0}; E(acc, u, wr, wc, fr, fq); } break;
    case 1: { EpiQ E{(bf16*)d.p0, (const float*)d.p3, (const float*)d.p4, d.i0}; E(acc, u, wr, wc, fr, fq); } break;
    case 2: { EpiKn E{(bf16*)d.p0, (const float*)d.p3}; E(acc, u, wr, wc, fr, fq); } break;
    case 3: { EpiVt E{(bf16*)d.p0, (const float*)d.p3}; E(acc, u, wr, wc, fr, fq); } break;
    case 4: { EpiRes E{(const float*)d.p1, (float*)d.p0}; E(acc, u, wr, wc, fr, fq); } break;
    case 5: { EpiUp E{(bf16*)d.p0}; E(acc, u, wr, wc, fr, fq); } break;
    case 6: { EpiBig E{(bf16*)d.p0, (bf16*)d.p1, (bf16*)d.p2, (bf16*)d.p3}; E(acc, u, wr, wc, fr, fq); } break;
    case 8: break;
    default: { EpiPlain E{(bf16*)d.p0, d.i0}; E(acc, u, wr, wc, fr, fq); } break;
    }
}
constexpr unsigned CW_SEAM = 16384, SEAM_BANK = 64 * 64;
constexpr size_t XBUF_OFF = 256 * 1024;
__device__ __forceinline__ void panel_stats(const f32x4 (&v)[2][2][4][2], const Unit& u, int wr, int wc, int fr, int fq, LAS unsigned char* lds, int wid, int lane, unsigned long long* xbuf, unsigned* cnt, float eps) {
    LAS f32x2* Pl = (LAS f32x2*)lds; LAS f32x2* Sl = (LAS f32x2*)(lds + 8192);
#pragma unroll
    for (int ai = 0; ai < 2; ++ai)
#pragma unroll
        for (int m = 0; m < 4; ++m) {
            float s = 0.f;
#pragma unroll
            for (int bj = 0; bj < 2; ++bj)
#pragma unroll
                for (int n = 0; n < 2; ++n) { const f32x4 x = v[ai][bj][m][n]; s += (x[0] + x[1]) + (x[2] + x[3]); }
            s += __shfl_xor(s, 16); s += __shfl_xor(s, 32);
            const float mw = s * (1.0f / 64.0f); float q = 0.f;
#pragma unroll
            for (int bj = 0; bj < 2; ++bj)
#pragma unroll
                for (int n = 0; n < 2; ++n) { const f32x4 dd = v[ai][bj][m][n] - mw; q += (dd[0] * dd[0] + dd[1] * dd[1]) + (dd[2] * dd[2] + dd[3] * dd[3]); }
            q += __shfl_xor(q, 16); q += __shfl_xor(q, 32);
            if (fq == 0) Pl[(ai * HALF + wr * 64 + m * 16 + fr) * 4 + wc] = (f32x2){mw, q};
            __builtin_amdgcn_sched_barrier(0);
        }
    asm volatile("s_waitcnt lgkmcnt(0)" ::: "memory"); __builtin_amdgcn_s_barrier(); asm volatile("" ::: "memory");
    const int row = wid * 32 + (lane & 31);
    if (lane < 32) {
        const f32x2 a = Pl[row * 4 + 0], b = Pl[row * 4 + 1], c = Pl[row * 4 + 2], dd = Pl[row * 4 + 3];
        const float mt = (a[0] + b[0] + c[0] + dd[0]) * 0.25f;
        const float da = a[0] - mt, db = b[0] - mt, dc = c[0] - mt, de = dd[0] - mt;
        const float m2 = (a[1] + b[1]) + (c[1] + dd[1]) + 64.0f * ((da * da + db * db) + (dc * dc + de * de));
        unsigned long long* slot = xbuf + ((size_t)(u.pm * BM + row) * 4 + u.pn);
        __hip_atomic_store(slot, ((unsigned long long)__builtin_bit_cast(unsigned, m2) << 32) | __builtin_bit_cast(unsigned, mt), __ATOMIC_RELAXED, __HIP_MEMORY_SCOPE_AGENT);
    }
    asm volatile("s_waitcnt vmcnt(0)" ::: "memory");
    if (lane == 0) __hip_atomic_fetch_add(cnt + 64 * u.pm, 1u, __ATOMIC_RELAXED, __HIP_MEMORY_SCOPE_AGENT);
    if (wid == 0) {
        for (unsigned sp = 0; sp < (1u << 22); ++sp) {
            if ((unsigned)__builtin_amdgcn_readfirstlane(__hip_atomic_load(cnt + 64 * u.pm, __ATOMIC_RELAXED, __HIP_MEMORY_SCOPE_AGENT)) >= 32u) break;
            __builtin_amdgcn_s_sleep(2);
        }
        __builtin_amdgcn_fence(__ATOMIC_ACQUIRE, "agent");
    }
    asm volatile("s_waitcnt vmcnt(0) lgkmcnt(0)" ::: "memory"); __builtin_amdgcn_s_barrier(); asm volatile("" ::: "memory");
    if (lane < 32) {
        const unsigned long long* slot = xbuf + (size_t)(u.pm * BM + row) * 4; float mt[4], m2[4]; float ms = 0.f;
#pragma unroll
        for (int t = 0; t < 4; ++t) { const unsigned long long w = __hip_atomic_load(slot + t, __ATOMIC_RELAXED, __HIP_MEMORY_SCOPE_AGENT); mt[t] = __builtin_bit_cast(float, (unsigned)w); m2[t] = __builtin_bit_cast(float, (unsigned)(w >> 32)); ms += mt[t]; }
        const float mean = ms * 0.25f; float q = 0.f;
#pragma unroll
        for (int t = 0; t < 4; ++t) { const float dm = mt[t] - mean; q += m2[t] + 256.0f * dm * dm; }
        Sl[row] = (f32x2){mean, 1.0f / sqrtf(q * (1.0f / 1024.0f) + eps)};
    }
    asm volatile("s_waitcnt lgkmcnt(0)" ::: "memory"); __builtin_amdgcn_s_barrier(); asm volatile("" ::: "memory");
}
__device__ __forceinline__ void fused_ln(const GemmDesc& d, f32x4 (&acc)[2][2][4][2], const Unit& u, int wr, int wc, int fr, int fq, LAS unsigned char* lds, int wid, int lane, unsigned char* ws) {
    const float* res = (const float*)d.p1; float* out = (float*)d.p0; const float* g = (const float*)d.p2; const float* b = (const float*)d.p3; bf16* xb = (bf16*)d.p4;
    const int col0 = u.pn * BM + wc * 32 + 4 * fq;
#pragma unroll
    for (int ai = 0; ai < 2; ++ai) {
        f32x4 rr[4][2][2];
#pragma unroll
        for (int m = 0; m < 4; ++m) {
            const size_t off = (size_t)(u.pm * BM + ai * HALF + wr * 64 + m * 16 + fr) * DM + col0;
#pragma unroll
            for (int bj = 0; bj < 2; ++bj)
#pragma unroll
                for (int n = 0; n < 2; ++n) rr[m][bj][n] = *(const f32x4*)(res + off + bj * HALF + n * 16);
        }
#pragma unroll
        for (int m = 0; m < 4; ++m) {
#pragma unroll
            for (int bj = 0; bj < 2; ++bj)
#pragma unroll
                for (int n = 0; n < 2; ++n) acc[ai][bj][m][n] = rr[m][bj][n] * ALPHA + acc[ai][bj][m][n];
            asm volatile("" : "+v"(acc[ai][0][m][0]), "+v"(acc[ai][0][m][1]), "+v"(acc[ai][1][m][0]), "+v"(acc[ai][1][m][1]));
        }
        asm volatile("" ::: "memory"); __builtin_amdgcn_sched_barrier(0);
    }
    panel_stats(acc, u, wr, wc, fr, fq, lds, wid, lane, (unsigned long long*)(ws + XBUF_OFF), (unsigned*)ws + CW_SEAM + (unsigned)d.i0 * SEAM_BANK, LN_EPS);
    const LAS f32x2* Sl = (const LAS f32x2*)(lds + 8192);
    int fr2 = fr, fq2 = fq; asm volatile("" : "+v"(fr2), "+v"(fq2));
    asm volatile("" : "+s"(g), "+s"(b), "+s"(out), "+s"(xb));
    const int col0b = u.pn * BM + wc * 32 + 4 * fq2;
#pragma unroll
    for (int ai = 0; ai < 2; ++ai)
#pragma unroll
        for (int m = 0; m < 4; ++m) {
            const int r = ai * HALF + wr * 64 + m * 16 + fr2; const f32x2 sr = Sl[r];
            const size_t off = (size_t)(u.pm * BM + r) * DM + col0b;
#pragma unroll
            for (int bj = 0; bj < 2; ++bj)
#pragma unroll
                for (int n = 0; n < 2; ++n) {
                    const f32x4 gg = *(const f32x4*)(g + col0b + bj * HALF + n * 16), bb = *(const f32x4*)(b + col0b + bj * HALF + n * 16);
                    const f32x4 o = (acc[ai][bj][m][n] - sr[0]) * sr[1] * gg + bb;
                    *(f32x4*)(out + off + bj * HALF + n * 16) = o;
                    if (xb) st_bf16x4(xb + off + bj * HALF + n * 16, o);
                }
            asm volatile("" ::: "memory"); __builtin_amdgcn_sched_barrier(0);
        }
}
}

__device__ __forceinline__ void p0_item(const Job& J, int item, LAS float* scr, int lane) {
    const int kb = item / J.nnb, nb = item % J.nnb, k0 = 64 * kb;
    const int scol = J.col0 + (nb / J.cpb) * J.cstride + (nb % J.cpb) * 32;
    float vals[32];
    const int kmax = J.Ksrc - 1, hk = lane >> 5, ln = lane & 31;
    const float* sp = J.src + scol + ln;
#pragma unroll
    for (int i = 0; i < 32; ++i) { const int k = k0 + 2 * i + hk; const int kc = k < kmax ? k : kmax; vals[i] = sp[(size_t)kc * J.ld_src]; }
    if (J.ksc) {
#pragma unroll
        for (int i = 0; i < 32; ++i) { const int k = k0 + 2 * i + hk; const int kc = k < kmax ? k : kmax; vals[i] *= J.ksc[kc]; }
    }
#pragma unroll
    for (int i = 0; i < 32; ++i) { const int kk = 2 * i + hk; scr[kk * 33 + ln] = (k0 + kk <= kmax) ? vals[i] : 0.f; }
    asm volatile("s_waitcnt lgkmcnt(0)" ::: "memory");
    const int c = lane & 7;
#pragma unroll
    for (int j = 0; j < 4; ++j) { const int n = (lane >> 3) + 8 * j; const LAS float* s = scr + (8 * c) * 33 + n;
        u32x4 o; o.x = cvtpk(s[0 * 33], s[1 * 33]); o.y = cvtpk(s[2 * 33], s[3 * 33]); o.z = cvtpk(s[4 * 33], s[5 * 33]); o.w = cvtpk(s[6 * 33], s[7 * 33]);
        *(u32x4*)(J.dst + (size_t)(J.row0 + nb * 32 + n) * J.ld_dst + J.kcol0 + k0 + 8 * c) = o; }
    asm volatile("s_waitcnt lgkmcnt(0)" ::: "memory");
}
__constant__ float ROPE_HI[16] = {1.591549367e-01f, 8.949939907e-02f, 5.032921210e-02f, 2.830219641e-02f, 1.591549441e-02f, 8.949940093e-03f, 5.032921210e-03f, 2.830219688e-03f, 1.591549488e-03f, 8.949940093e-04f, 5.032921326e-04f, 2.830219455e-04f, 1.591549371e-04f, 8.949940093e-05f, 5.032921035e-05f, 2.830219637e-05f};
__constant__ float ROPE_LO[16] = {6.420638243e-09f, 2.542919653e-09f, 5.173299289e-12f, -5.826552019e-10f, -1.029942243e-10f, 6.802745173e-11f, 5.173301024e-13f, -1.048316434e-10f, -5.686555046e-11f, 6.802744999e-12f, -1.158979943e-11f, 1.279990003e-11f, 5.954976963e-12f, 6.802745216e-13f, 1.751403167e-12f, -5.389994549e-13f};

namespace attn {
constexpr int KSTR = 208, VSTR = 136;
constexpr int KBYTES = 64 * KSTR, VBYTES = 64 * VSTR, BUFB = KBYTES + VBYTES;
constexpr int OST_OFF = 45056, OST_WAVE = 32 * 144;
__device__ __forceinline__ int crow(int r, int hi) { return (r & 3) + 8 * (r >> 2) + 4 * hi; }

__device__ __forceinline__ void unit(LAS unsigned char* lds, const bf16* __restrict__ Q, const bf16* __restrict__ Kn, const bf16* __restrict__ Kr, const bf16* __restrict__ Vt, bf16* __restrict__ O,
                                     int tokbase, int S, int h, int qb, const int tid) {
    const int lane = tid & 63, r32 = lane & 31, hi = lane >> 5, wid = __builtin_amdgcn_readfirstlane(tid >> 6);
    const int NT = S / 64;
    const int qrow = tokbase + qb * 256 + wid * 32 + r32;
    bf16x8 qf[6];
#pragma unroll
    for (int d0 = 0; d0 < 6; ++d0) qf[d0] = *(const bf16x8*)(Q + (size_t)qrow * 1536 + h * 96 + d0 * 16 + hi * 8);
    const int kkey = tid >> 3, kch = tid & 7;
    const int rkey = (tid & 255) >> 2, rch = tid & 3;
    const int vd = tid >> 3, vch = tid & 7;
    const bf16* kp = Kn + (size_t)(tokbase + kkey) * 1024 + h * 64 + kch * 8;
    const bf16* rp = Kr + (size_t)(tokbase + rkey) * 32 + rch * 8;
    const bf16* vp = Vt + (size_t)(h * 64 + vd) * MH + tokbase + vch * 8;
    u32x4 kreg, rreg = {0, 0, 0, 0}, vreg;
    kreg = *(const u32x4*)kp; if (tid < 256) rreg = *(const u32x4*)rp; vreg = *(const u32x4*)vp;
#define ATT_WRITE(buf) do { LAS unsigned char* b_ = lds + (buf) * BUFB; \
        *(LAS u32x4*)(b_ + kkey * KSTR + kch * 16) = kreg; \
        if (tid < 256) *(LAS u32x4*)(b_ + rkey * KSTR + 128 + rch * 16) = rreg; \
        *(LAS u32x2*)(b_ + KBYTES + vd * VSTR + vch * 16) = (u32x2){vreg.x, vreg.y}; \
        *(LAS u32x2*)(b_ + KBYTES + vd * VSTR + vch * 16 + 8) = (u32x2){vreg.z, vreg.w}; } while (0)
    ATT_WRITE(0);
    __syncthreads();
    float mref = 0.f, l_run = 0.f;
    f32x16 o0 = {}, o1 = {};
#define MAX3(a, b, c) ({ float r_; asm("v_max3_f32 %0, %1, %2, %3" : "=v"(r_) : "v"(a), "v"(b), "v"(c)); r_; })
    for (int t = 0; t < NT; ++t) {
        if (t + 1 < NT) {
            kreg = *(const u32x4*)(kp + (size_t)(t + 1) * 64 * 1024);
            if (tid < 256) rreg = *(const u32x4*)(rp + (size_t)(t + 1) * 64 * 32);
            vreg = *(const u32x4*)(vp + (size_t)(t + 1) * 64);
        }
        const LAS unsigned char* kb = lds + (t & 1) * BUFB;
        const LAS unsigned char* vb = kb + KBYTES;
        f32x16 p0 = {}, p1 = {};
        {
            bf16x8 kf0[6], kf1[6];
#pragma unroll
            for (int d0 = 0; d0 < 6; ++d0) { kf0[d0] = *(const LAS bf16x8*)(kb + r32 * KSTR + d0 * 32 + hi * 16); kf1[d0] = *(const LAS bf16x8*)(kb + (32 + r32) * KSTR + d0 * 32 + hi * 16); }
            __builtin_amdgcn_sched_barrier(0);
#pragma unroll
            for (int d0 = 0; d0 < 6; ++d0) { p0 = __builtin_amdgcn_mfma_f32_32x32x16_bf16(kf0[d0], qf[d0], p0, 0, 0, 0); p1 = __builtin_amdgcn_mfma_f32_32x32x16_bf16(kf1[d0], qf[d0], p1, 0, 0, 0); }
        }
        float mx = MAX3(p0[0], p0[1], p0[2]);
        mx = MAX3(mx, p0[3], p0[4]); mx = MAX3(mx, p0[5], p0[6]); mx = MAX3(mx, p0[7], p0[8]); mx = MAX3(mx, p0[9], p0[10]); mx = MAX3(mx, p0[11], p0[12]);
        mx = MAX3(mx, p0[13], p0[14]); mx = MAX3(mx, p0[15], p1[0]); mx = MAX3(mx, p1[1], p1[2]); mx = MAX3(mx, p1[3], p1[4]); mx = MAX3(mx, p1[5], p1[6]);
        mx = MAX3(mx, p1[7], p1[8]); mx = MAX3(mx, p1[9], p1[10]); mx = MAX3(mx, p1[11], p1[12]); mx = MAX3(mx, p1[13], p1[14]); mx = MAX3(mx, p1[15], p1[15]);
        { const float mo = __shfl_xor(mx, 32); mx = MAX3(mx, mo, mo); }
        if (__any(mx - mref > 8.0f)) {
            const float dl = fmaxf(mx - mref, 0.f);
            mref += dl;
            const float alpha = __builtin_amdgcn_exp2f(-dl);
            l_run *= alpha;
#pragma unroll
            for (int r = 0; r < 16; ++r) { o0[r] *= alpha; o1[r] *= alpha; }
        }
        if (__any(mref != 0.f)) {
            float la = 0.f, lb = 0.f, lc = 0.f, ld = 0.f;
#pragma unroll
            for (int r = 0; r < 16; r += 2) { p0[r] = __builtin_amdgcn_exp2f(p0[r] - mref); p1[r] = __builtin_amdgcn_exp2f(p1[r] - mref); p0[r + 1] = __builtin_amdgcn_exp2f(p0[r + 1] - mref); p1[r + 1] = __builtin_amdgcn_exp2f(p1[r + 1] - mref);
                la += p0[r]; lb += p1[r]; lc += p0[r + 1]; ld += p1[r + 1]; }
            l_run += (la + lb) + (lc + ld);
        } else {
            float la = 0.f, lb = 0.f, lc = 0.f, ld = 0.f;
#pragma unroll
            for (int r = 0; r < 16; r += 2) { p0[r] = __builtin_amdgcn_exp2f(p0[r]); p1[r] = __builtin_amdgcn_exp2f(p1[r]); p0[r + 1] = __builtin_amdgcn_exp2f(p0[r + 1]); p1[r + 1] = __builtin_amdgcn_exp2f(p1[r + 1]);
                la += p0[r]; lb += p1[r]; lc += p0[r + 1]; ld += p1[r + 1]; }
            l_run += (la + lb) + (lc + ld);
        }
        bf16x8 pb[2][2];
#pragma unroll
        for (int s = 0; s < 2; ++s) {
            u32x4 w0 = {cvtpk(p0[8 * s + 0], p0[8 * s + 1]), cvtpk(p0[8 * s + 2], p0[8 * s + 3]), cvtpk(p0[8 * s + 4], p0[8 * s + 5]), cvtpk(p0[8 * s + 6], p0[8 * s + 7])};
            u32x4 w1 = {cvtpk(p1[8 * s + 0], p1[8 * s + 1]), cvtpk(p1[8 * s + 2], p1[8 * s + 3]), cvtpk(p1[8 * s + 4], p1[8 * s + 5]), cvtpk(p1[8 * s + 6], p1[8 * s + 7])};
            pb[0][s] = __builtin_bit_cast(bf16x8, w0); pb[1][s] = __builtin_bit_cast(bf16x8, w1);
        }
        {
            bf16x8 vfa[2][2], vfb[2][2];
#pragma unroll
            for (int kt = 0; kt < 2; ++kt)
#pragma unroll
                for (int s = 0; s < 2; ++s) {
                    const int kcol = (kt * 32 + 16 * s + 4 * hi) * 2;
                    const u32x2 a0 = *(const LAS u32x2*)(vb + r32 * VSTR + kcol), a1 = *(const LAS u32x2*)(vb + r32 * VSTR + kcol + 16);
                    const u32x2 b0 = *(const LAS u32x2*)(vb + (32 + r32) * VSTR + kcol), b1 = *(const LAS u32x2*)(vb + (32 + r32) * VSTR + kcol + 16);
                    vfa[kt][s] = __builtin_bit_cast(bf16x8, (u32x4){a0.x, a0.y, a1.x, a1.y});
                    vfb[kt][s] = __builtin_bit_cast(bf16x8, (u32x4){b0.x, b0.y, b1.x, b1.y});
                }
            __builtin_amdgcn_sched_barrier(0);
#pragma unroll
            for (int kt = 0; kt < 2; ++kt)
#pragma unroll
                for (int s = 0; s < 2; ++s) {
                    o0 = __builtin_amdgcn_mfma_f32_32x32x16_bf16(vfa[kt][s], pb[kt][s], o0, 0, 0, 0);
                    o1 = __builtin_amdgcn_mfma_f32_32x32x16_bf16(vfb[kt][s], pb[kt][s], o1, 0, 0, 0);
                }
        }
        if (t + 1 < NT) ATT_WRITE((t + 1) & 1);
        __syncthreads();
    }
#undef ATT_WRITE
    l_run += __shfl_xor(l_run, 32);
    const float inv = 1.0f / l_run;
    LAS unsigned char* stg = lds + OST_OFF + wid * OST_WAVE;
#pragma unroll
    for (int r = 0; r < 16; ++r) { const int d = crow(r, hi);
        *(LAS bf16*)(stg + r32 * 144 + d * 2) = f2bf(o0[r] * inv);
        *(LAS bf16*)(stg + r32 * 144 + (32 + d) * 2) = f2bf(o1[r] * inv); }
    asm volatile("s_waitcnt lgkmcnt(0)" ::: "memory");
    bf16* Ow = O + (size_t)(tokbase + qb * 256 + wid * 32) * 1024 + h * 64;
#pragma unroll
    for (int i = 0; i < 4; ++i) { const int row = i * 8 + (lane >> 3), ch = lane & 7; const u32x4 v = *(const LAS u32x4*)(stg + row * 144 + ch * 16); *(u32x4*)(Ow + (size_t)row * 1024 + ch * 8) = v; }
    __syncthreads();
}
}

__device__ __forceinline__ void ln_regs(f32x4 (&v)[4], const float* g, const float* b, int lane) {
    float s = 0.f;
#pragma unroll
    for (int j = 0; j < 4; ++j) s += (v[j][0] + v[j][1]) + (v[j][2] + v[j][3]);
    const float mean = wave_sum(s) * (1.0f / DM); float s2 = 0.f;
#pragma unroll
    for (int j = 0; j < 4; ++j) { v[j] = v[j] - mean; s2 += (v[j][0] * v[j][0] + v[j][1] * v[j][1]) + (v[j][2] * v[j][2] + v[j][3] * v[j][3]); }
    const float rstd = __builtin_amdgcn_rsqf(wave_sum(s2) * (1.0f / DM) + LN_EPS);
#pragma unroll
    for (int j = 0; j < 4; ++j) { const f32x4 gg = *(const f32x4*)(g + 256 * j + 4 * lane), bb = *(const f32x4*)(b + 256 * j + 4 * lane); v[j] = v[j] * rstd * gg + bb; }
}
__device__ __forceinline__ void ld_row(f32x4 (&v)[4], const float* p, int lane) {
#pragma unroll
    for (int j = 0; j < 4; ++j) v[j] = *(const f32x4*)(p + 256 * j + 4 * lane);
}
__device__ __forceinline__ void st_row(const f32x4 (&v)[4], float* p, int lane) {
#pragma unroll
    for (int j = 0; j < 4; ++j) *(f32x4*)(p + 256 * j + 4 * lane) = v[j];
}
__device__ __forceinline__ void st_row_bf16(const f32x4 (&v)[4], bf16* p, int lane) {
#pragma unroll
    for (int j = 0; j < 4; ++j) pg8::st_bf16x4(p + 256 * j + 4 * lane, v[j]);
}

namespace scan {
constexpr int T = 32, SSTR = 400;
constexpr int BUF_FLOATS = T * SSTR;
constexpr int WB_OFF = 2 * BUF_FLOATS * 4;
constexpr int WB_STR = 144;

struct Prob { int e, h, tokbase, S, row0; };
struct PrepRegs { bf16x8 twA[2], alA[2]; u32x2 kx[4], rx[4], vx[4]; };

__device__ __forceinline__ int tok_of(const Prob& P, int tau) { return P.tokbase + (P.e ? (P.S - 1 - tau) : tau); }
__device__ __forceinline__ float xsum4(float v) { v += __shfl_xor(v, 16); v += __shfl_xor(v, 32); return v; }
__device__ __forceinline__ f32x4 bf4(u32x2 v) { return (f32x4){__builtin_bit_cast(float, v.x << 16), __builtin_bit_cast(float, v.x & 0xffff0000u), __builtin_bit_cast(float, v.y << 16), __builtin_bit_cast(float, v.y & 0xffff0000u)}; }

__device__ __forceinline__ void prep_load(PrepRegs& R, const Prob& P, int c, int st0, int lane,
                                          const bf16* __restrict__ Rb, const bf16* __restrict__ Kb, const bf16* __restrict__ Vb, const bf16* __restrict__ Lb) {
    const int c16 = lane & 15, q = lane >> 4;
    const int tok = tok_of(P, c * T + st0 + c16);
#pragma unroll
    for (int ks = 0; ks < 2; ++ks) {
        R.twA[ks] = *(const bf16x8*)(Lb + (size_t)tok * 512 + P.e * 64 + ks * 32 + 8 * q);
        R.alA[ks] = *(const bf16x8*)(Lb + (size_t)tok * 512 + 128 + P.e * 64 + ks * 32 + 8 * q);
    }
    const size_t o = (size_t)tok * DM + P.h * 64 + 4 * q;
#pragma unroll
    for (int nt = 0; nt < 4; ++nt) { R.kx[nt] = *(const u32x2*)(Kb + o + nt * 16); R.rx[nt] = *(const u32x2*)(Rb + o + nt * 16); R.vx[nt] = *(const u32x2*)(Vb + o + nt * 16); }
}
__device__ __forceinline__ void prep_compute(LAS float* buf, LAS unsigned char* wlds, const PrepRegs& R, const Prob& P, int c, int st0, int lane, float* coef) {
    const int c16 = lane & 15, q = lane >> 4;
    const LAS float* cst = (const LAS float*)(wlds + 2 * 64 * WB_STR) + 4 * q;
    const LAS unsigned char* wfr = wlds + c16 * WB_STR + q * 16;
    asm volatile("" : "+v"(cst), "+v"(wfr));
    f32x4 accw[4], acca[4];
#pragma unroll
    for (int nt = 0; nt < 4; ++nt) {
        accw[nt] = (f32x4){0.f, 0.f, 0.f, 0.f}; acca[nt] = (f32x4){0.f, 0.f, 0.f, 0.f};
#pragma unroll
        for (int ks = 0; ks < 2; ++ks) {
            const bf16x8 wB = *(const LAS bf16x8*)(wfr + nt * 16 * WB_STR + ks * 64);
            const bf16x8 aB = *(const LAS bf16x8*)(wfr + 64 * WB_STR + nt * 16 * WB_STR + ks * 64);
            accw[nt] = __builtin_amdgcn_mfma_f32_16x16x32_bf16(wB, R.twA[ks], accw[nt], 0, 0, 0);
            acca[nt] = __builtin_amdgcn_mfma_f32_16x16x32_bf16(aB, R.alA[ks], acca[nt], 0, 0, 0);
        }
    }
    const int st = st0 + c16;
    const int tok = tok_of(P, c * T + st);
    LAS float* rec = buf + st * SSTR + 4 * q;
    asm volatile("" : "+v"(rec));
    f32x4 kf[4], rf[4], av[4], kkr[4];
    float ss = 0.f;
#pragma unroll
    for (int nt = 0; nt < 4; ++nt) {
        const int ch0 = nt * 16;
        const f32x4 a0v = *(const LAS f32x4*)(cst + 64 + ch0), kkv = *(const LAS f32x4*)(cst + 128 + ch0);
        kf[nt] = bf4(R.kx[nt]); rf[nt] = bf4(R.rx[nt]);
#pragma unroll
        for (int e = 0; e < 4; ++e) { av[nt][e] = sigmoidf_(a0v[e] + acca[nt][e]); kkr[nt][e] = kf[nt][e] * kkv[e]; ss += kkr[nt][e] * kkr[nt][e]; }
    }
    ss = xsum4(ss);
    const float inv = __builtin_amdgcn_rsqf(fmaxf(ss, 1e-24f));
    float cf = 0.f, br = 0.f, kr = 0.f;
#pragma unroll
    for (int nt = 0; nt < 4; ++nt) {
        const int ch0 = nt * 16;
        const f32x4 w0v = *(const LAS f32x4*)(cst + ch0), kav = *(const LAS f32x4*)(cst + 192 + ch0), rkv = *(const LAS f32x4*)(cst + 256 + ch0);
        f32x4 nk, wv, bv, kdv, wrv;
#pragma unroll
        for (int e = 0; e < 4; ++e) {
            const float u = sigmoidf_(w0v[e] + accw[nt][e]);
            const float w = __builtin_amdgcn_exp2f(-0.8750387749145276f * u);
            const float kk = kkr[nt][e] * inv;
            const float kd = kf[nt][e] * (1.0f + (av[nt][e] - 1.0f) * kav[e]);
            const float b = kk * av[nt][e];
            cf += rf[nt][e] * kd * rkv[e]; br += b * rf[nt][e]; kr += kd * rf[nt][e];
            nk[e] = -kk; wv[e] = w; bv[e] = b; kdv[e] = kd; wrv[e] = w * rf[nt][e];
        }
        *(LAS f32x4*)(rec + ch0) = nk; *(LAS f32x4*)(rec + 64 + ch0) = wv; *(LAS f32x4*)(rec + 128 + ch0) = bv; *(LAS f32x4*)(rec + 192 + ch0) = kdv; *(LAS f32x4*)(rec + 256 + ch0) = wrv;
        *(LAS f32x4*)(rec + 320 + ch0) = bf4(R.vx[nt]);
    }
    cf = xsum4(cf); br = xsum4(br); kr = xsum4(kr);
    if (q == 0) { coef[((size_t)P.e * MH + tok) * NH + P.h] = cf; *(LAS f32x2*)(rec + 384) = (f32x2){br, kr};     }
}

template <int L, int NSW, int PW0, int NPAIR, int PD>
__device__ __forceinline__ void run(LAS unsigned char* lds, const Prob& P, const bf16* Rb, const bf16* Kb, const bf16* Vb, const bf16* Lb, const bf16* w2t, const bf16* a2t,
                                    const float* w0, const float* a0, const float* k_k, const float* k_a, const float* r_k, bf16* Yb, float* coef, const int tid_in, const int pm) {
    constexpr int EPL = 64 / L, RPW = 64 / L, NG = EPL / 4;
    int tid = tid_in; asm volatile("" : "+v"(tid));
    const int lane = tid & 63, wid = __builtin_amdgcn_readfirstlane(tid >> 6);
    LAS float* bufs = (LAS float*)lds;
    LAS unsigned char* wlds = lds + WB_OFF;
    const bool is_prep = (wid >= PW0 && wid < PW0 + 2 * NPAIR);
    const int pw = wid - PW0, st0 = (pw & 1) * 16;
    for (int i = tid; i < 2 * 64 * 8; i += 512) {
        const int m = i >> 9, chn = (i >> 3) & 63, kc = i & 7;
        const bf16* src = (m ? a2t : w2t) + ((size_t)P.e * 1024 + P.h * 64 + chn) * 64 + kc * 8;
        *(LAS u32x4*)(wlds + m * 64 * WB_STR + chn * WB_STR + kc * 16) = *(const u32x4*)src;
    }
    { LAS float* cstw = (LAS float*)(wlds + 2 * 64 * WB_STR); const int hch = P.h * 64 + lane;
      if (wid == 0) cstw[lane] = w0[P.e * 1024 + hch];
      if (wid == 1) cstw[64 + lane] = a0[P.e * 1024 + hch];
      if (wid == 2) cstw[128 + lane] = k_k[hch];
      if (wid == 3) cstw[192 + lane] = k_a[hch];
      if (wid == 4) cstw[256 + lane] = r_k[hch]; }
    const int NC = P.S / T;
    PrepRegs R;
    int lc = pw >> 1;
    if (is_prep) prep_load(R, P, lc, st0, lane, Rb, Kb, Vb, Lb);
    __syncthreads();
    if (is_prep && lc == 0) { prep_compute(bufs, wlds, R, P, 0, st0, lane, coef); lc += NPAIR; if (lc < NC) prep_load(R, P, lc, st0, lane, Rb, Kb, Vb, Lb); }
    __syncthreads();
    const int s = lane & (L - 1), rloc = lane / L;
    const int row = P.row0 + wid * RPW + rloc;
#define SCAN_BAR() asm volatile("s_waitcnt lgkmcnt(0)\n\ts_barrier" ::: "memory")
    if (is_prep) {
        for (int c = 0; c < NC; ++c) {
            if (lc == c + 1 && lc < NC) {
                if (!(pm & 1)) prep_compute(bufs + ((c + 1) & 1) * BUF_FLOATS, wlds, R, P, c + 1, st0, lane, coef);
                asm volatile("" ::: "memory"); __builtin_amdgcn_sched_barrier(0);
                lc += NPAIR; if (lc < NC) prep_load(R, P, lc, st0, lane, Rb, Kb, Vb, Lb);
                asm volatile("" ::: "memory"); __builtin_amdgcn_sched_barrier(0);
            }
            SCAN_BAR();
        }
    } else {
        float St[EPL];
#pragma unroll
        for (int e = 0; e < EPL; ++e) St[e] = 0.f;
        float ykeep = 0.f;
        for (int c = 0; c < NC; ++c) {
        if (wid < NSW && !(pm & 2)) {
            const LAS float* buf = bufs + (c & 1) * BUF_FLOATS;
            const LAS float* lb = buf + 4 * s; const LAS float* lv = buf + 320 + row;
            asm volatile("" : "+v"(lb), "+v"(lv));
            f32x4 naA[NG], wrA[NG], naB[NG], wrB[NG], w[NG], b[NG], kd[NG]; float vi; f32x2 sc;
#define SCAN_LOAD_NW(NA, WR, st_) do { const LAS float* rec_ = lb + (st_) * SSTR; \
                _Pragma("unroll") for (int g4 = 0; g4 < NG; ++g4) { const int j0 = g4 * (4 * L); NA[g4] = *(const LAS f32x4*)(rec_ + j0); WR[g4] = *(const LAS f32x4*)(rec_ + 256 + j0); } } while (0)
#define SCAN_LOAD_REST(st_) do { const LAS float* rec_ = lb + (st_) * SSTR; \
                _Pragma("unroll") for (int g4 = 0; g4 < NG; ++g4) { const int j0 = g4 * (4 * L); \
                    w[g4] = *(const LAS f32x4*)(rec_ + 64 + j0); b[g4] = *(const LAS f32x4*)(rec_ + 128 + j0); kd[g4] = *(const LAS f32x4*)(rec_ + 192 + j0); } \
                vi = lv[(st_) * SSTR]; sc = *(const LAS f32x2*)(buf + (st_) * SSTR + 384); } while (0)
#define SCAN_STEP(NA, WR, st_) do { \
                f32x2 a1_ = {0.f, 0.f}, a2_ = {0.f, 0.f}; \
                _Pragma("unroll") for (int g4 = 0; g4 < NG; ++g4) _Pragma("unroll") for (int e = 0; e < 4; e += 2) { \
                    const f32x2 s2_ = {St[g4 * 4 + e], St[g4 * 4 + e + 1]}; \
                    a1_ = s2_ * (f32x2){NA[g4][e], NA[g4][e + 1]} + a1_; a2_ = s2_ * (f32x2){WR[g4][e], WR[g4][e + 1]} + a2_; } \
                float d1 = a1_[0] + a1_[1], d2 = a2_[0] + a2_[1]; \
                if (L == 16) { d1 = allred16(d1); d2 = allred16(d2); } else if (L == 8) { d1 = allred8(d1); d2 = allred8(d2); } else { d1 = allred4(d1); d2 = allred4(d2); } \
                const float sa = d1, cv = vi; \
                const float y = d2 + sa * sc[0] + cv * sc[1]; \
                _Pragma("unroll") for (int g4 = 0; g4 < NG; ++g4) _Pragma("unroll") for (int e = 0; e < 4; ++e) St[g4 * 4 + e] = St[g4 * 4 + e] * w[g4][e] + (sa * b[g4][e] + cv * kd[g4][e]); \
                ykeep = (s == ((st_) & (L - 1))) ? y : ykeep; \
                if (((st_) & (L - 1)) == L - 1 && !(pm & 4)) { \
                    const int tok = tok_of(P, c * T + ((st_) - (L - 1)) + s); \
                    Yb[((size_t)P.e * MH + tok) * DM + P.h * 64 + row] = f2bf(ykeep); \
                } } while (0)
            SCAN_LOAD_NW(naA, wrA, 0);
#pragma unroll 1
            for (int st = 0; st < T; st += 2) {
                SCAN_LOAD_REST(st);
                SCAN_LOAD_NW(naB, wrB, st + 1);
                SCAN_STEP(naA, wrA, st);
                __builtin_amdgcn_sched_barrier(0);
                SCAN_LOAD_REST(st + 1);
                if (st + 2 < T) SCAN_LOAD_NW(naA, wrA, st + 2);
                SCAN_STEP(naB, wrB, st + 1);
                __builtin_amdgcn_sched_barrier(0);
            }
#undef SCAN_LOAD_NW
#undef SCAN_LOAD_REST
#undef SCAN_STEP
        }
            SCAN_BAR();
        }
    }
#undef SCAN_BAR
}
}

#define XB_TMO      128
#define XB_XCNT(j)  (256  + 64 * (j))
#define XB_XSUB(j)  (1280 + 64 * (j))
#define XB_XGEN(j)  (2304 + 64 * (j))
#define XB_TOP      3328
#define XB_TOPGEN   3392
#define XCD_BAR_WORDS 3456
#define XB_SPIN_CAP (1u << 22)
__device__ __forceinline__ unsigned xb_ld(unsigned* p)              { return __hip_atomic_load(p, __ATOMIC_RELAXED, __HIP_MEMORY_SCOPE_AGENT); }
__device__ __forceinline__ unsigned xb_add(unsigned* p, unsigned v) { return __hip_atomic_fetch_add(p, v, __ATOMIC_RELAXED, __HIP_MEMORY_SCOPE_AGENT); }
__device__ __forceinline__ unsigned xb_xcc_id() { return (unsigned)__builtin_amdgcn_s_getreg((3 << 11) | 20) & 0xFu; }
#define XB_SPIN(cond, bar) do { unsigned _sp = 0; while (cond) { __builtin_amdgcn_s_sleep(1); \
    if ((++_sp & 255u) == 0u) { if (xb_ld(&(bar)[XB_TMO])) break; if (_sp > XB_SPIN_CAP) { atomicAdd(&(bar)[XB_TMO], 1u); break; } } } } while (0)
__device__ __forceinline__ void xcd_barrier_complete(unsigned* bar, unsigned x, unsigned& nloc, unsigned& nx) {
    const unsigned G = gridDim.x * gridDim.y * gridDim.z;
    unsigned sum, cnt, mine, sp = 0u;
    for (;;) {
        sum = 0u; cnt = 0u; mine = 0u;
#pragma unroll
        for (unsigned j = 0; j < 16; ++j) { const unsigned c = xb_ld(&bar[XB_XCNT(j)]); sum += c; cnt += (c > 0u) ? 1u : 0u; mine = (j == x) ? c : mine; }
        if (sum == G) break;
        __builtin_amdgcn_s_sleep(1);
        if ((++sp & 255u) == 0u) { if (xb_ld(&bar[XB_TMO])) break; if (sp > XB_SPIN_CAP) { atomicAdd(&bar[XB_TMO], 1u); break; } }
    }
    nloc = mine > 0u ? mine : 1u; nx = cnt > 0u ? cnt : 1u;
}
__device__ __forceinline__ void xcd_barrier(unsigned* bar, volatile LAS unsigned* st) {
    asm volatile("s_waitcnt vmcnt(0)" ::: "memory");
    __syncthreads();
    if (threadIdx.x == 0) {
        const unsigned x = xb_xcc_id();
        __builtin_amdgcn_s_waitcnt(0);
        unsigned nloc = st[0], nx = st[1];
        if (nloc == 0u) { xcd_barrier_complete(bar, x, nloc, nx); st[0] = nloc; st[1] = nx; }
        const unsigned old = xb_add(&bar[XB_XSUB(x)], 1u);
        const unsigned gen = old / nloc;
        if (old + 1u == (gen + 1u) * nloc) {
            __builtin_amdgcn_fence(__ATOMIC_RELEASE, "agent");
            asm volatile("s_waitcnt vmcnt(0)" ::: "memory");
            const unsigned og = xb_add(&bar[XB_TOP], 1u);
            const unsigned tg = og / nx;
            if (og + 1u == (tg + 1u) * nx) xb_add(&bar[XB_TOPGEN], 1u);
            else XB_SPIN(xb_ld(&bar[XB_TOPGEN]) == tg, bar);
            __builtin_amdgcn_fence(__ATOMIC_ACQUIRE, "agent");
            xb_add(&bar[XB_XGEN(x)], 1u);
            asm volatile("s_waitcnt vmcnt(0)" ::: "memory");
        } else {
            XB_SPIN(xb_ld(&bar[XB_XGEN(x)]) == gen, bar);
            __builtin_amdgcn_fence(__ATOMIC_ACQUIRE, "agent");
            asm volatile("s_waitcnt vmcnt(0)" ::: "memory");
        }
    }
    __syncthreads();
}

__global__ void __launch_bounds__(512, 2) fwd(Args args_unused) {
    extern __shared__ __attribute__((aligned(16))) unsigned char lds_raw[];
    LAS unsigned char* lds = (LAS unsigned char*)lds_raw;
    typedef pg8::ArgP ArgP;
    const ArgP ap0 = (ArgP)__builtin_amdgcn_kernarg_segment_ptr();
    const int ph_lo = ap0->ph_lo, ph_hi = ap0->ph_hi;
    const int wid0 = __builtin_amdgcn_readfirstlane((int)threadIdx.x >> 6);
    volatile LAS unsigned* bar_st = (volatile LAS unsigned*)(lds + 131072 + 64);
    if (threadIdx.x == 0) { bar_st[0] = 0u; bar_st[1] = 0u; }
    __syncthreads();
    if (ap0->coop && threadIdx.x == 0) (void)xb_add((unsigned*)ap0->ws + XB_XCNT(xb_xcc_id()), 1u);

    int rep_cnt = 0; (void)rep_cnt;
    for (int ph = ph_lo; ph < ph_hi; ++ph) {
        ArgP ap = ap0; asm volatile("" : "+s"(ap));
        int tid; asm volatile("v_mbcnt_lo_u32_b32 %0, -1, 0\n\tv_mbcnt_hi_u32_b32 %0, -1, %0" : "=v"(tid)); tid += wid0 * 64;
        asm volatile("" : "+v"(tid));
#define args (*ap)
        unsigned char* ws = args.ws;
        const bf16* Win_t = (const bf16*)(ws + OFF_WIN); const bf16* Wqb_t = (const bf16*)(ws + OFF_WQB); const bf16* Wk_t = (const bf16*)(ws + OFF_WK); const bf16* Wv_t = (const bf16*)(ws + OFF_WV);
        const bf16* Wo0_t = (const bf16*)(ws + OFF_WO0); const bf16* Wbig_t = (const bf16*)(ws + OFF_WBIG); const bf16* Bg_t = (const bf16*)(ws + OFF_BG); const bf16* Wo1_t = (const bf16*)(ws + OFF_WO1);
        const bf16* w2t = (const bf16*)(ws + OFF_W2T); const bf16* a2t = (const bf16*)(ws + OFF_A2T);
        float* rope = (float*)(ws + OFF_ROPE);
        const int half = ph / NPH, k = ph % NPH;
        const float* xin = args.in[half];
        float* DH = args.out + (size_t)half * MH * DM;
        const int S = half ? 8192 : 2048, nseq = half ? 2 : 8, smask = S - 1;
        {
            int nsub = 0;
            if (k == 1 || k == 4 || k == 6 || k == 7 || k == 9 || k == 12 || k == 14 || k == 16 || k == 17) nsub = 1;
            if (k == 2) nsub = 3;
            if constexpr (CASE_ON(1)) {
#pragma unroll 1
            for (int sub = 0; sub < nsub; ++sub) pg8::gemm_phase(lds, ph, sub, ap0, (int)gridDim.x, (int)blockIdx.x, tid);
            }
        }
        int G = gridDim.x, bx = blockIdx.x; asm volatile("" : "+s"(G), "+s"(bx));
        const int lane = tid & 63, wave = __builtin_amdgcn_readfirstlane(tid >> 6);
        const int vcu = (G % 8 == 0) ? (bx % 8) * (G / 8) + bx / 8 : bx;
        const int gw = vcu * 8 + wave, NGW = G * 8;
        switch (k) {
        case 0: { if constexpr (CASE_ON(0)) {
            if (half == 0) {
                unsigned zz_ = 0u; asm volatile("" : "+v"(zz_)); const u32x4 zero4 = {zz_, zz_, zz_, zz_};
                LAS float* scr = (LAS float*)(lds + wave * 16384);
                const int nitems = args.njobs_items;
                for (int it = gw; it < nitems; it += NGW) {
                    int j = 0;
#pragma unroll
                    for (int jj = 1; jj < NJOBS; ++jj) if (it >= args.jobs[jj].item0) j = jj;
                    Job J; { const __attribute__((address_space(4))) Job* jp = &args.jobs[j]; J.src = jp->src; J.ksc = jp->ksc; J.dst = jp->dst; J.ld_src = jp->ld_src; J.Ksrc = jp->Ksrc; J.col0 = jp->col0; J.cpb = jp->cpb; J.cstride = jp->cstride; J.ld_dst = jp->ld_dst; J.row0 = jp->row0; J.kcol0 = jp->kcol0; J.nkt = jp->nkt; J.nnb = jp->nnb; J.item0 = jp->item0; }
                    p0_item(J, it - J.item0, scr, lane);
                }
                { u32x4* z = (u32x4*)(ws + OFF_WIN + (size_t)1056 * 1024 * 2); const int n = 224 * 1024 * 2 / 16; for (int i = gw * 64 + lane; i < n; i += NGW * 64) z[i] = zero4; }
                { u32x4* z = (u32x4*)(ws + OFF_WBIG + (size_t)3488 * 2048 * 2); const int n = 96 * 2048 * 2 / 16; for (int i = gw * 64 + lane; i < n; i += NGW * 64) z[i] = zero4; }
                for (int i = gw * 64 + lane; i < 8192 * 16; i += NGW * 64) {
                    const int pos = i >> 4, fi = i & 15;
                    const float pf = (float)pos, hi_ = ROPE_HI[fi], lo_ = ROPE_LO[fi];
                    const float pr = pf * hi_, er = __builtin_fmaf(pf, hi_, -pr);
                    float fr_ = pr - __builtin_floorf(pr); fr_ += (er + pf * lo_);
                    const float c = __builtin_amdgcn_cosf(fr_), s = __builtin_amdgcn_sinf(fr_);
                    rope[2 * i] = c; rope[2 * i + 1] = s;
                }
            }
            bf16* xb = (bf16*)(ws + A_XB);
            {
                const size_t n8 = (size_t)MH * DM / 8, stride = (size_t)NGW * 64;
                size_t i = (size_t)gw * 64 + lane;
                for (; i + 15 * stride < n8; i += 16 * stride) {
                    f32x4 a[16], b[16];
#pragma unroll
                    for (int u = 0; u < 16; ++u) { a[u] = *(const f32x4*)(xin + (i + u * stride) * 8); b[u] = *(const f32x4*)(xin + (i + u * stride) * 8 + 4); }
#pragma unroll
                    for (int u = 0; u < 16; ++u) pg8::st_bf16x8(xb + (i + u * stride) * 8, a[u], b[u]);
                }
                for (; i < n8; i += stride) { const f32x4 a = *(const f32x4*)(xin + i * 8), b = *(const f32x4*)(xin + i * 8 + 4); pg8::st_bf16x8(xb + i * 8, a, b); }
            }
        } } break;
        case 3: { if constexpr (CASE_ON(3)) {
            const int nqb = S / 256, nunits = nseq * NH * nqb, upc = (nunits + G - 1) / G;
            for (int i = 0; i < upc; ++i) {
                const int id = vcu * upc + i; if (id >= nunits) break;
                const int sh = id / nqb, qb = id % nqb, seq = sh / NH, h = sh % NH;
                attn::unit(lds, (const bf16*)(ws + A_Q), (const bf16*)(ws + A_KN), (const bf16*)(ws + A_KROPE), (const bf16*)(ws + A_VT), (bf16*)(ws + A_O), seq * S, S, h, qb, tid);
            }
        } } break;
        case 5: case 15: { if constexpr (CASE_ON(5)) {
            if (k == 5 || k == 15) break;
            const int layer = (k == 5) ? 0 : 1;
            const float* src = (k == 5) ? DH : (const float*)(ws + A_X2);
            const float* gg = args.in[28] + layer * DM; const float* bb = args.in[29] + layer * DM;
            bf16* xnb = (bf16*)(ws + A_XNB);
            for (int r = gw; r < MH; r += NGW) { f32x4 v[4]; ld_row(v, src + (size_t)r * DM, lane); ln_regs(v, gg, bb, lane); st_row(v, DH + (size_t)r * DM, lane); st_row_bf16(v, xnb + (size_t)r * DM, lane); }
        } } break;
        case 8: { if constexpr (CASE_ON(8)) {
            const float* gg = args.in[30]; const float* bb = args.in[31];
            float* x2 = (float*)(ws + A_X2); bf16* A2 = (bf16*)(ws + A_A2);
            for (int ch = gw; ch < MH / 8; ch += NGW) {
                const int t0 = ch * 8;
                f32x4 prev[4], cur[4], nxt[4];
                if ((t0 & smask) != 0) { ld_row(prev, DH + (size_t)(t0 - 1) * DM, lane); ln_regs(prev, gg, bb, lane); }
                else {
#pragma unroll
                    for (int j = 0; j < 4; ++j) prev[j] = (f32x4){0.f, 0.f, 0.f, 0.f}; }
                ld_row(cur, DH + (size_t)t0 * DM, lane); ln_regs(cur, gg, bb, lane);
#pragma unroll 1
                for (int i = 0; i < 8; ++i) {
                    const int t = t0 + i;
                    if ((t & smask) != smask) { ld_row(nxt, DH + (size_t)(t + 1) * DM, lane); ln_regs(nxt, gg, bb, lane); }
                    else {
#pragma unroll
                        for (int j = 0; j < 4; ++j) nxt[j] = (f32x4){0.f, 0.f, 0.f, 0.f}; }
                    st_row(cur, x2 + (size_t)t * DM, lane);
                    st_row_bf16(cur, A2 + (size_t)t * 2048, lane);
                    f32x4 xx[4];
#pragma unroll
                    for (int j = 0; j < 4; ++j) xx[j] = (prev[j] + nxt[j]) * 0.5f - cur[j];
                    st_row_bf16(xx, A2 + (size_t)t * 2048 + 1024, lane);
#pragma unroll
                    for (int j = 0; j < 4; ++j) { prev[j] = cur[j]; cur[j] = nxt[j]; }
                }
            }
        } } break;
        case 10: { if constexpr (CASE_ON(10)) {
        } } break;
        case 11: { if constexpr (CASE_ON(11)) {
            const bf16* Rb = (const bf16*)DH; const bf16* Kb = (const bf16*)DH + (size_t)MH * DM; const bf16* Vb = (const bf16*)(ws + A_V); const bf16* Lb = (const bf16*)(ws + A_L);
            bf16* Y = (bf16*)(ws + A_Y); float* coef = (float*)(ws + A_COEF);
#if defined(PROBE_MASK)
            const int pmode = (rep_cnt == half) ? PROBE_MASK : 0;
#else
            const int pmode = 0;
#endif
            if (half == 0) {
                for (int p = bx; p < 2 * 8 * NH; p += G) {
                    scan::Prob P; P.e = p / (8 * NH); P.h = p % NH; P.tokbase = ((p / NH) % 8) * S; P.S = S; P.row0 = 0;
                    scan::run<4, 4, 4, 2, 1>(lds, P, Rb, Kb, Vb, Lb, w2t, a2t, args.in[13], args.in[16], args.in[21], args.in[22], args.in[23], Y, coef, tid, pmode);
                }
            } else {
                for (int p = bx; p < 2 * 2 * NH * 4; p += G) {
                    const int pr = p >> 2;
                    scan::Prob P; P.e = pr / (2 * NH); P.h = pr % NH; P.tokbase = ((pr / NH) % 2) * S; P.S = S; P.row0 = (p & 3) * 16;
                    scan::run<16, 4, 4, 2, 1>(lds, P, Rb, Kb, Vb, Lb, w2t, a2t, args.in[13], args.in[16], args.in[21], args.in[22], args.in[23], Y, coef, tid, pmode);
                }
            }
        } } break;
        case 13: { if constexpr (CASE_ON(13)) {
            const bf16* Y = (const bf16*)(ws + A_Y); const float* coef = (const float*)(ws + A_COEF); const bf16* Vb = (const bf16*)(ws + A_V); const bf16* Gb = (const bf16*)DH;
            bf16* Op = (bf16*)(ws + A_OPOST);
            const float* lg = args.in[24]; const float* lb = args.in[25];
            for (int r = gw; r < MH; r += NGW) {
#pragma unroll
                for (int j = 0; j < 4; ++j) {
                    const int c0 = 256 * j + 4 * lane, h = c0 >> 6;
                    const u32x2 y0 = *(const u32x2*)(Y + (size_t)r * DM + c0), y1 = *(const u32x2*)(Y + ((size_t)MH + r) * DM + c0);
                    f32x4 y = {__builtin_bit_cast(float, y0.x << 16) + __builtin_bit_cast(float, y1.x << 16), __builtin_bit_cast(float, y0.x & 0xffff0000u) + __builtin_bit_cast(float, y1.x & 0xffff0000u),
                               __builtin_bit_cast(float, y0.y << 16) + __builtin_bit_cast(float, y1.y << 16), __builtin_bit_cast(float, y0.y & 0xffff0000u) + __builtin_bit_cast(float, y1.y & 0xffff0000u)};
                    float s = (y[0] + y[1]) + (y[2] + y[3]); s = allred16(s);
                    const float mu = s * (1.0f / 64.0f);
                    y = y - mu;
                    float s2 = (y[0] * y[0] + y[1] * y[1]) + (y[2] * y[2] + y[3] * y[3]); s2 = allred16(s2);
                    const float rstd = __builtin_amdgcn_rsqf(s2 * (1.0f / 64.0f) + GN_EPS);
                    const float cf = coef[(size_t)r * NH + h] + coef[((size_t)MH + r) * NH + h];
                    const u32x2 vv = *(const u32x2*)(Vb + (size_t)r * DM + c0), gv = *(const u32x2*)(Gb + (size_t)r * DM + c0);
                    const f32x4 v = {__builtin_bit_cast(float, vv.x << 16), __builtin_bit_cast(float, vv.x & 0xffff0000u), __builtin_bit_cast(float, vv.y << 16), __builtin_bit_cast(float, vv.y & 0xffff0000u)};
                    const f32x4 gq = {__builtin_bit_cast(float, gv.x << 16), __builtin_bit_cast(float, gv.x & 0xffff0000u), __builtin_bit_cast(float, gv.y << 16), __builtin_bit_cast(float, gv.y & 0xffff0000u)};
                    const f32x4 gg = *(const f32x4*)(lg + c0), bb = *(const f32x4*)(lb + c0);
                    const f32x4 o = (y * rstd * gg + bb + v * cf) * gq;
                    pg8::st_bf16x4(Op + (size_t)r * DM + c0, o);
                }
            }
        } } break;
        case 18: { if constexpr (CASE_ON(18)) {
        } } break;
        default: break;
        }
#if defined(REP_LO)
        if (k == REP_HI && rep_cnt == half) { ph -= (REP_HI - REP_LO + 1); ++rep_cnt; }
#endif
        if (ph + 1 < ph_hi && args.coop && k != 10 && k != 5 && k != 15 && k != 18) {
            if (ph == ph_lo) cg::this_grid().sync();
            else xcd_barrier((unsigned*)args.ws, bar_st);
        }
#undef args
    }
}

extern "C" void kernel_launch(void* const* d_in, const int* in_sizes, int n_in, void* d_out, int out_size, void* d_ws, size_t ws_size, hipStream_t stream) {
    static int grid = 0;
    if (grid == 0) {
        if (n_in != 32 || ws_size < WS_NEED || out_size != 2 * MH * DM) { fprintf(stderr, "kernel_launch: unexpected problem (n_in %d, ws %zu, out %d)\n", n_in, ws_size, out_size); grid = -1; return; }
        int dev = 0, cus = 0;
        if (hipGetDevice(&dev) != hipSuccess || hipDeviceGetAttribute(&cus, hipDeviceAttributeMultiprocessorCount, dev) != hipSuccess) { grid = -1; return; }
        if (hipFuncSetAttribute((const void*)fwd, hipFuncAttributeMaxDynamicSharedMemorySize, LDS_BYTES) != hipSuccess) { fprintf(stderr, "kernel_launch: hipFuncSetAttribute failed\n"); grid = -1; return; }
        int per_cu = 0;
        if (hipOccupancyMaxActiveBlocksPerMultiprocessor(&per_cu, (const void*)fwd, 512, LDS_BYTES) != hipSuccess || per_cu < 1) fprintf(stderr, "kernel_launch: occupancy query reports %d\n", per_cu);
        (void)hipGetLastError();
        grid = cus;
    }
    if (grid < 0) return;
    Args a{};
    for (int i = 0; i < 32; ++i) a.in[i] = (const float*)d_in[i];
    a.out = (float*)d_out; a.ws = (unsigned char*)d_ws;
    unsigned char* ws = (unsigned char*)d_ws;
    int nj = 0, items = 0;
    auto add = [&](const float* src, const float* ksc, size_t dst_off, int ld_src, int Ksrc, int col0, int cpb, int cstride, int ld_dst, int row0, int kcol0, int nkt, int nnb) {
        Job& J = a.jobs[nj++]; J.src = src; J.ksc = ksc; J.dst = (bf16*)(ws + dst_off); J.ld_src = ld_src; J.Ksrc = Ksrc; J.col0 = col0; J.cpb = cpb; J.cstride = cstride;
        J.ld_dst = ld_dst; J.row0 = row0; J.kcol0 = kcol0; J.nkt = nkt; J.nnb = nnb; J.item0 = items; items += nkt * nnb; };
    const float* const* in = a.in;
    const float* mix = in[8];
    add(in[2], nullptr, OFF_WIN, 1056, 1024, 0, 33, 0, 1024, 0, 0, 16, 33);
    add(in[5], in[3], OFF_WQB, 1536, 768, 0, 48, 0, 768, 0, 0, 12, 48);
    add(in[6], in[4], OFF_WK, 2048, 256, 0, 2, 128, 256, 0, 0, 4, 32);
    add(in[6], in[4], OFF_WV, 2048, 256, 64, 2, 128, 256, 0, 0, 4, 32);
    add(in[7], nullptr, OFF_WO0, 1024, 1024, 0, 32, 0, 1024, 0, 0, 16, 32);
    for (int l = 0; l < 2; ++l) add(in[26] + (size_t)l * 1024 * 4096, nullptr, OFF_W1 + (size_t)l * 4096 * 1024 * 2, 4096, 1024, 0, 128, 0, 1024, 0, 0, 16, 128);
    for (int l = 0; l < 2; ++l) add(in[27] + (size_t)l * 4096 * 1024, nullptr, OFF_W2 + (size_t)l * 4096 * 1024 * 2, 1024, 4096, 0, 32, 0, 4096, 0, 0, 64, 32);
    { const int widx[3] = {9, 10, 11}, midx[3] = {0, 2, 3};
      for (int t = 0; t < 3; ++t) { add(in[widx[t]], nullptr, OFF_WBIG, 1024, 1024, 0, 32, 0, 2048, 1024 * t, 0, 16, 32);
                                    add(in[widx[t]], mix + midx[t] * 1024, OFF_WBIG, 1024, 1024, 0, 32, 0, 2048, 1024 * t, 1024, 16, 32); } }
    for (int e = 0; e < 2; ++e) { add(in[14] + (size_t)e * 1024 * 64, nullptr, OFF_WBIG, 64, 1024, 0, 2, 0, 2048, 3072 + 64 * e, 0, 16, 2);
                                  add(in[14] + (size_t)e * 1024 * 64, mix + 1 * 1024, OFF_WBIG, 64, 1024, 0, 2, 0, 2048, 3072 + 64 * e, 1024, 16, 2); }
    for (int e = 0; e < 2; ++e) { add(in[17] + (size_t)e * 1024 * 64, nullptr, OFF_WBIG, 64, 1024, 0, 2, 0, 2048, 3200 + 64 * e, 0, 16, 2);
                                  add(in[17] + (size_t)e * 1024 * 64, mix + 4 * 1024, OFF_WBIG, 64, 1024, 0, 2, 0, 2048, 3200 + 64 * e, 1024, 16, 2); }
    add(in[19], nullptr, OFF_WBIG, 160, 1024, 0, 5, 0, 2048, 3328, 0, 16, 5);
    add(in[19], mix + 5 * 1024, OFF_WBIG, 160, 1024, 0, 5, 0, 2048, 3328, 1024, 16, 5);
    add(in[20], nullptr, OFF_BG, 1024, 160, 0, 32, 0, 256, 0, 0, 4, 32);
    add(in[12], nullptr, OFF_WO1, 1024, 1024, 0, 32, 0, 1024, 0, 0, 16, 32);
    for (int e = 0; e < 2; ++e) add(in[15] + (size_t)e * 64 * 1024, nullptr, OFF_W2T + (size_t)e * 1024 * 64 * 2, 1024, 64, 0, 32, 0, 64, 0, 0, 1, 32);
    for (int e = 0; e < 2; ++e) add(in[18] + (size_t)e * 64 * 1024, nullptr, OFF_A2T + (size_t)e * 1024 * 64 * 2, 1024, 64, 0, 32, 0, 64, 0, 0, 1, 32);
    a.njobs_items = items;
#if ONE_LAUNCH
    a.ph_lo = 0; a.ph_hi = 2 * NPH; a.coop = 1;
    if (hipMemsetAsync(d_ws, 0, 196608, stream) != hipSuccess) { fprintf(stderr, "kernel_launch: hipMemsetAsync failed\n"); return; }
    void* kargs[] = {&a};
    hipError_t e = hipLaunchCooperativeKernel((const void*)fwd, dim3(grid), dim3(512), kargs, LDS_BYTES, stream);
    if (e != hipSuccess) fprintf(stderr, "cooperative launch failed: %s (grid %d)\n", hipGetErrorString(e), grid);
#else
    a.coop = 0;
    for (int ph = 0; ph < 2 * NPH; ++ph) { a.ph_lo = ph; a.ph_hi = ph + 1; fwd<<<dim3(grid), dim3(512), LDS_BYTES, stream>>>(a); }
#endif
}
```
